# Optimizing an MI355X kernel written in HIP

```python
import math
import jax, jax.numpy as jnp
from jax import lax
import numpy as np

D_MODEL = 1024
BATCH = 4
SEQ = 4096
DEPTH = 4
DEC_BATCH = 128
DEC_SEQ = 1
PAST_LEN = 8192
PAGE_SIZE = 128

N_A_LAYERS = DEPTH // 2
N_B_LAYERS = DEPTH - N_A_LAYERS
GROUP_SIZE = 16
N_GROUPS = D_MODEL // GROUP_SIZE
STATE_DIM = 64
DT_MIN = 1e-3
DT_MAX = 1e-1
HEAD_DIM = 64
N_HEADS = D_MODEL // HEAD_DIM
N_KV_HEADS = 4
Q_PER_KV = N_HEADS // N_KV_HEADS
WINDOW = 128
ROPE_THETA = 10000.0
D_FF = 4 * D_MODEL
EPS = 1e-6

kernel_name = "yoco_s5_swa_sink_decoder_step"


def rms_norm(x, g):
    x32 = x.astype(jnp.float32)
    y = x32 * lax.rsqrt(jnp.mean(x32 * x32, axis=-1, keepdims=True) + EPS)
    return (y * g.astype(jnp.float32)).astype(x.dtype)


def rope(x, pos):
    half = HEAD_DIM // 2
    inv = ROPE_THETA ** (-jnp.arange(half, dtype=jnp.float32) / half)
    ang = pos.astype(jnp.float32)[:, None] * inv[None, :]
    cos = jnp.cos(ang)[:, None, :]
    sin = jnp.sin(ang)[:, None, :]
    x32 = x.astype(jnp.float32)
    x1, x2 = x32[..., :half], x32[..., half:]
    out = jnp.concatenate([x1 * cos - x2 * sin, x2 * cos + x1 * sin], axis=-1)
    return out.astype(x.dtype)


def s5_discretize(a_re, a_im, log_dt, b_re, b_im):
    dt = jnp.exp(log_dt.astype(jnp.float32))
    lam = lax.complex(a_re.astype(jnp.float32), a_im.astype(jnp.float32))
    lam_bar = jnp.exp(lam * dt)
    b = lax.complex(b_re.astype(jnp.float32), b_im.astype(jnp.float32))
    b_bar = ((lam_bar - 1.0) / lam)[..., None] * b
    return lam_bar, b_bar


def s5_mixer(u, s0, lam_bar, b_bar, c, d_skip, w_glu, b_glu):
    bsz, seq_len, _ = u.shape
    u32 = u.astype(jnp.float32)
    ug = u32.reshape(bsz, seq_len, N_GROUPS, GROUP_SIZE).astype(jnp.complex64)
    bu = jnp.einsum('blgc,gpc->blgp', ug, b_bar)
    if s0 is not None:
        bu = bu.at[:, 0].add(lam_bar * s0)
    a = jnp.broadcast_to(lam_bar, (1, seq_len) + lam_bar.shape)

    def combine(e1, e2):
        a1, b1 = e1
        a2, b2 = e2
        return a1 * a2, a2 * b1 + b2

    _, s = lax.associative_scan(combine, (a, bu), axis=1)
    y = jnp.real(jnp.einsum('blgp,gcp->blgc', s, c)).reshape(bsz, seq_len, D_MODEL)
    y = y + d_skip.astype(jnp.float32) * u32
    g = jax.nn.gelu(y).astype(u.dtype)
    z = g @ w_glu + b_glu
    out = z[..., :D_MODEL] * jax.nn.sigmoid(z[..., D_MODEL:])
    return out.astype(u.dtype), s[:, -1]


def sq_relu_mlp(h, w_in, w_out):
    return jnp.square(jax.nn.relu(h @ w_in)) @ w_out


def shared_kv(x, g_kv, w_k, w_v, k_gain, pos):
    bsz, seq_len, _ = x.shape
    h = rms_norm(x, g_kv)
    k = (h @ w_k).reshape(bsz, seq_len, N_KV_HEADS, HEAD_DIM)
    k = rope(rms_norm(k, k_gain), pos)
    v = (h @ w_v).reshape(bsz, seq_len, N_KV_HEADS, HEAD_DIM)
    return k, v


def queries(x, g, w_q, q_gain, pos):
    bsz, seq_len, _ = x.shape
    h = rms_norm(x, g)
    q = (h @ w_q).reshape(bsz, seq_len, N_HEADS, HEAD_DIM)
    q = rope(rms_norm(q, q_gain), pos)
    return q.reshape(bsz, seq_len, N_KV_HEADS, Q_PER_KV, HEAD_DIM)


def sink_attention(q, k, v, qpos, kpos, sinks):
    s = jnp.einsum('...qhgd,...khd->...hgqk', q.astype(jnp.float32), k.astype(jnp.float32)) * (HEAD_DIM ** -0.5)
    diff = qpos[..., :, None] - kpos[..., None, :]
    valid = (diff >= 0) & (diff < WINDOW) & (kpos[..., None, :] >= 0)
    s = jnp.where(valid[..., None, None, :, :], s, -jnp.inf)
    sink = sinks.astype(jnp.float32).reshape(N_KV_HEADS, Q_PER_KV)[:, :, None, None]
    m = jnp.maximum(jnp.max(s, axis=-1, keepdims=True), sink)
    p = jnp.exp(s - m)
    denom = jnp.sum(p, axis=-1, keepdims=True) + jnp.exp(sink - m)
    o = jnp.einsum('...hgqk,...khd->...qhgd', p / denom, v.astype(jnp.float32))
    return o.astype(q.dtype)


def swa_prompt(q, k, v, pos, sinks):
    bsz, seq_len = q.shape[:2]
    nb = seq_len // WINDOW
    qb = q.reshape(bsz, nb, WINDOW, N_KV_HEADS, Q_PER_KV, HEAD_DIM)

    def with_prev(t):
        tb = t.reshape(bsz, nb, WINDOW, N_KV_HEADS, HEAD_DIM)
        prev = jnp.concatenate([jnp.zeros_like(tb[:, :1]), tb[:, :-1]], axis=1)
        return jnp.concatenate([prev, tb], axis=2)

    qpos = pos.reshape(nb, WINDOW)
    kpos = jnp.concatenate([qpos - WINDOW, qpos], axis=1)
    o = sink_attention(qb, with_prev(k), with_prev(v), qpos, kpos, sinks)
    return o.reshape(bsz, seq_len, N_HEADS * HEAD_DIM)


def setup_inputs(seed: int = 0) -> dict:
    key = jax.random.key(seed)
    ks = jax.random.split(key, 32)
    f32 = jnp.float32

    def nrm(k, shape, scale):
        return jax.random.normal(k, shape, f32) * scale

    cache_rows = min(WINDOW, PAST_LEN)
    ssm_shape = (N_A_LAYERS, N_GROUPS, STATE_DIM)
    n_idx = jnp.arange(STATE_DIM, dtype=f32)
    return {
        'x_prompt': nrm(ks[0], (BATCH, SEQ, D_MODEL), 1.0),
        'x_sample': nrm(ks[1], (DEC_BATCH, DEC_SEQ, D_MODEL), 1.0),
        'state_ssm_re': nrm(ks[2], (N_A_LAYERS, DEC_BATCH, N_GROUPS, STATE_DIM), 0.1),
        'state_ssm_im': nrm(ks[3], (N_A_LAYERS, DEC_BATCH, N_GROUPS, STATE_DIM), 0.1),
        'cache_k': nrm(ks[4], (DEC_BATCH, cache_rows, N_KV_HEADS, HEAD_DIM), 1.0),
        'cache_v': nrm(ks[5], (DEC_BATCH, cache_rows, N_KV_HEADS, HEAD_DIM), 1.0),
        'norm_mix': 1.0 + nrm(ks[6], (DEPTH, D_MODEL), 0.02),
        'norm_mlp': 1.0 + nrm(ks[7], (DEPTH, D_MODEL), 0.02),
        'ssm_a_re': -0.5 + nrm(ks[8], ssm_shape, 0.01),
        'ssm_a_im': math.pi * n_idx + nrm(ks[9], ssm_shape, 0.01),
        'ssm_log_dt': jax.random.uniform(ks[10], ssm_shape, f32, math.log(DT_MIN), math.log(DT_MAX)),
        'ssm_b_re': nrm(ks[11], (N_A_LAYERS, N_GROUPS, STATE_DIM, GROUP_SIZE), (2 * GROUP_SIZE) ** -0.5),
        'ssm_b_im': nrm(ks[12], (N_A_LAYERS, N_GROUPS, STATE_DIM, GROUP_SIZE), (2 * GROUP_SIZE) ** -0.5),
        'ssm_c_re': nrm(ks[13], (N_A_LAYERS, N_GROUPS, GROUP_SIZE, STATE_DIM), STATE_DIM ** -0.5),
        'ssm_c_im': nrm(ks[14], (N_A_LAYERS, N_GROUPS, GROUP_SIZE, STATE_DIM), STATE_DIM ** -0.5),
        'ssm_d': nrm(ks[15], (N_A_LAYERS, D_MODEL), 1.0),
        'w_glu': nrm(ks[16], (N_A_LAYERS, D_MODEL, 2 * D_MODEL), D_MODEL ** -0.5),
        'b_glu': nrm(ks[17], (N_A_LAYERS, 2 * D_MODEL), 0.01),
        'norm_kv': 1.0 + nrm(ks[18], (D_MODEL,), 0.02),
        'w_k': nrm(ks[19], (D_MODEL, N_KV_HEADS * HEAD_DIM), D_MODEL ** -0.5),
        'w_v': nrm(ks[20], (D_MODEL, N_KV_HEADS * HEAD_DIM), D_MODEL ** -0.5),
        'k_norm': 1.0 + nrm(ks[21], (HEAD_DIM,), 0.02),
        'w_q': nrm(ks[22], (N_B_LAYERS, D_MODEL, N_HEADS * HEAD_DIM), D_MODEL ** -0.5),
        'q_norm': 1.0 + nrm(ks[23], (N_B_LAYERS, HEAD_DIM), 0.02),
        'attn_sinks': nrm(ks[24], (N_B_LAYERS, N_HEADS), 0.5),
        'w_o': nrm(ks[25], (N_B_LAYERS, N_HEADS * HEAD_DIM, D_MODEL), (N_HEADS * HEAD_DIM) ** -0.5),
        'w_mlp_in': nrm(ks[26], (DEPTH, D_MODEL, D_FF), D_MODEL ** -0.5),
        'w_mlp_out': nrm(ks[27], (DEPTH, D_FF, D_MODEL), D_FF ** -0.5),
    }


def reference(x_prompt, x_sample, state_ssm_re, state_ssm_im, cache_k, cache_v,
              norm_mix, norm_mlp, ssm_a_re, ssm_a_im, ssm_log_dt, ssm_b_re, ssm_b_im,
              ssm_c_re, ssm_c_im, ssm_d, w_glu, b_glu, norm_kv, w_k, w_v, k_norm,
              w_q, q_norm, attn_sinks, w_o, w_mlp_in, w_mlp_out):
    seq_p = x_prompt.shape[1]
    seq_s = x_sample.shape[1]
    pos_p = jnp.arange(seq_p, dtype=jnp.int32)
    pos_s = PAST_LEN + jnp.arange(seq_s, dtype=jnp.int32)
    n_cached = cache_k.shape[1]
    kpos_s = jnp.concatenate([PAST_LEN - n_cached + jnp.arange(n_cached, dtype=jnp.int32), pos_s])

    xp, xs = x_prompt, x_sample
    sp_re, sp_im, ss_re, ss_im = [], [], [], []
    kp = vp = k_all_s = v_all_s = None
    for layer in range(DEPTH):
        if layer < N_A_LAYERS:
            i = layer
            lam_bar, b_bar = s5_discretize(ssm_a_re[i], ssm_a_im[i], ssm_log_dt[i], ssm_b_re[i], ssm_b_im[i])
            c = lax.complex(ssm_c_re[i].astype(jnp.float32), ssm_c_im[i].astype(jnp.float32))
            s0 = lax.complex(state_ssm_re[i].astype(jnp.float32), state_ssm_im[i].astype(jnp.float32))
            yp, fin_p = s5_mixer(rms_norm(xp, norm_mix[layer]), None, lam_bar, b_bar, c, ssm_d[i], w_glu[i], b_glu[i])
            ys, fin_s = s5_mixer(rms_norm(xs, norm_mix[layer]), s0, lam_bar, b_bar, c, ssm_d[i], w_glu[i], b_glu[i])
            xp = xp + yp
            xs = xs + ys
            sp_re.append(jnp.real(fin_p))
            sp_im.append(jnp.imag(fin_p))
            ss_re.append(jnp.real(fin_s))
            ss_im.append(jnp.imag(fin_s))
        else:
            if layer == N_A_LAYERS:
                kp, vp = shared_kv(xp, norm_kv, w_k, w_v, k_norm, pos_p)
                ks_new, vs_new = shared_kv(xs, norm_kv, w_k, w_v, k_norm, pos_s)
                k_all_s = jnp.concatenate([cache_k.astype(ks_new.dtype), ks_new], axis=1)
                v_all_s = jnp.concatenate([cache_v.astype(vs_new.dtype), vs_new], axis=1)
            j = layer - N_A_LAYERS
            qp = queries(xp, norm_mix[layer], w_q[j], q_norm[j], pos_p)
            qs = queries(xs, norm_mix[layer], w_q[j], q_norm[j], pos_s)
            op = swa_prompt(qp, kp, vp, pos_p, attn_sinks[j])
            os_ = sink_attention(qs, k_all_s, v_all_s, pos_s, kpos_s, attn_sinks[j])
            os_ = os_.reshape(xs.shape[0], seq_s, N_HEADS * HEAD_DIM)
            xp = xp + op @ w_o[j]
            xs = xs + os_ @ w_o[j]
        xp = xp + sq_relu_mlp(rms_norm(xp, norm_mlp[layer]), w_mlp_in[layer], w_mlp_out[layer])
        xs = xs + sq_relu_mlp(rms_norm(xs, norm_mlp[layer]), w_mlp_in[layer], w_mlp_out[layer])

    keep_p = min(WINDOW, seq_p)
    keep_s = min(WINDOW, PAST_LEN + seq_s)
    return (xp, xs,
            jnp.stack(sp_re), jnp.stack(sp_im), kp[:, -keep_p:], vp[:, -keep_p:],
            jnp.stack(ss_re), jnp.stack(ss_im), k_all_s[:, -keep_s:], v_all_s[:, -keep_s:])
```

```cpp
#include <hip/hip_runtime.h>
#include <hip/hip_cooperative_groups.h>
#include <cstdio>
#include <cstdint>
#include <cmath>
namespace cg = cooperative_groups;
#ifndef MULTI
#define MULTI 0
#endif
namespace pg8 {
#define PG8_LAS __attribute__((address_space(3)))
typedef unsigned short bf16_t;
typedef short bf16x8 __attribute__((ext_vector_type(8)));
typedef float f32x4 __attribute__((ext_vector_type(4)));
typedef unsigned u32x4 __attribute__((ext_vector_type(4)));
constexpr int BM = 256, BK = 64, HALF = 128, HTB = HALF * BK * 2  , STAGE_BYTES = 8 * HTB, NXCD = 8, WGM = 8;

__host__ __device__ __forceinline__ int lds_byte(int r, int c) { const int st = (r >> 4) * 2 + (c >> 5), rr = r & 15, cc = c & 31, ob = rr * 64 + cc * 2; return st * 1024 + (ob ^ (((ob >> 9) & 1) << 5)); }
__host__ __device__ __forceinline__ void stage_rc(int b, int& R, int& C) { const int st = b / 1024, sb = b % 1024, swz = sb ^ (((sb >> 9) & 1) << 5); R = (st >> 1) * 16 + swz / 64; C = (st & 1) * 32 + (swz % 64) / 2; }
__host__ __device__ __forceinline__ int perm32(int rho) { const int n = rho >> 4, i = rho & 15; return 8 * (i >> 2) + 4 * n + (i & 3); }

struct Unit { int pm, pn; };
struct Gemm { const bf16_t* A; const bf16_t* Bt; int M, N, K; };

struct StaticOrder {
    int nM, nN, nwg, G, c;
    __host__ __device__ void init(int M, int N, int G_, int c_) { nM = M / BM; nN = N / BM; nwg = nM * nN; G = G_; c = c_; }
    __host__ __device__ bool next(int i, Unit& u) const {
        const long L = (long)i * G + c; if (L >= nwg) return false;
        int wgid = (int)L; { const int q = nwg / NXCD, r = nwg % NXCD, xcd = wgid % NXCD, off = wgid / NXCD; wgid = (xcd < r ? xcd * (q + 1) : r * (q + 1) + (xcd - r) * q) + off; }
        const int nig = WGM * nN, gid = wgid / nig, fm = gid * WGM, gsz = (nM - fm) < WGM ? (nM - fm) : WGM;
        u.pm = fm + ((wgid % nig) % gsz); u.pn = (wgid % nig) / gsz; return true;
    }
    __device__ __forceinline__ void a_ready(const Unit&) const {}
    __device__ __forceinline__ void done(const Unit&) const {}
};

__device__ __forceinline__ unsigned cvt_pk_bf16(float lo, float hi) { unsigned r; asm volatile("v_cvt_pk_bf16_f32 %0, %1, %2" : "=v"(r) : "v"(lo), "v"(hi)); return r; }
typedef float f32x2 __attribute__((ext_vector_type(2)));
template <class Epi, class Sched, bool ALIGN_EPI = false, bool SP2 = false>
__device__ __forceinline__ void gemm_phase(PG8_LAS unsigned char* lds, const Gemm g, const Sched& S, const Epi& E) {
    int tid_; asm volatile("v_mov_b32 %0, %1" : "=v"(tid_) : "v"((int)threadIdx.x)); const int tid = tid_, wid = __builtin_amdgcn_readfirstlane(tid >> 6), lane = tid & 63, wr = wid >> 2, wc = wid & 3, fr = lane & 15, fq = lane >> 4;
    const int K = g.K, nt = K / BK;
    unsigned voffA[2], voffB[2];
#pragma unroll
    for (int i = 0; i < 2; ++i) { int R, C; stage_rc(tid * 16 + i * 8192, R, C); const int Rb = Epi::PERM ? ((R & ~31) + perm32(R & 31)) : R;
        voffA[i] = (unsigned)(R * K + C) * 2u; voffB[i] = (unsigned)(Rb * K + C) * 2u; }
    const size_t kstep = (size_t)(BK * 2);
    const size_t hstep = (size_t)HALF * K * 2;
    const size_t tstep = 2 * hstep;
    const unsigned ldsw = (unsigned)wid * 1024u;
    const int aoff = lds_byte(wr * 64 + fr, fq * 8), boff = lds_byte(wc * 32 + fr, fq * 8);
#define PG8_SA(b, h) (((b) * 2 + (h)) * HTB)
#define PG8_SB(b, h) ((4 + (b) * 2 + (h)) * HTB)
#define PG8_STAGE(bufoff, gbase, voff) do { _Pragma("unroll") for (int _i = 0; _i < 2; ++_i) \
        __builtin_amdgcn_global_load_lds((const unsigned*)((const char*)(gbase) + (voff)[_i]), (PG8_LAS unsigned*)(lds + (bufoff) + ldsw + _i * 8192), 16, 0, 0); } while (0)
#define PG8_LDA(dst, b, h) do { _Pragma("unroll") for (int m = 0; m < 4; ++m) _Pragma("unroll") for (int k = 0; k < 2; ++k) dst[m][k] = *(const PG8_LAS bf16x8*)(lds + PG8_SA(b, h) + aoff + m * 2048 + k * 1024); } while (0)
#define PG8_LDB(dst, b, h) do { _Pragma("unroll") for (int n = 0; n < 2; ++n) _Pragma("unroll") for (int k = 0; k < 2; ++k) dst[n][k] = *(const PG8_LAS bf16x8*)(lds + PG8_SB(b, h) + boff + n * 2048 + k * 1024); } while (0)
#define PG8_MMA(ai, bj, At, Bt) do { __builtin_amdgcn_s_setprio(1); _Pragma("unroll") for (int m = 0; m < 4; ++m) _Pragma("unroll") for (int n = 0; n < 2; ++n) _Pragma("unroll") for (int k = 0; k < 2; ++k) \
        acc[ai][bj][m][n] = __builtin_amdgcn_mfma_f32_16x16x32_bf16(Bt[n][k], At[m][k], acc[ai][bj][m][n], 0, 0, 0); __builtin_amdgcn_s_setprio(0); } while (0)
#define PG8_WAIT_V(n) asm volatile("s_waitcnt vmcnt(" #n ")" ::: "memory")
#define PG8_WAIT_L(n) asm volatile("s_waitcnt lgkmcnt(" #n ")" ::: "memory")
#define PG8_BAR __builtin_amdgcn_s_barrier()
#define PG8_SCHED __builtin_amdgcn_sched_barrier(0)
    Unit cur, nxt; int ui = 0;
    if (!S.next(0, cur)) return;
    f32x4 acc[2][2][4][2];
#pragma unroll
    for (int a = 0; a < 2; ++a)
#pragma unroll
        for (int b = 0; b < 2; ++b)
#pragma unroll
            for (int m = 0; m < 4; ++m)
#pragma unroll
                for (int n = 0; n < 2; ++n) acc[a][b][m][n] = (f32x4){0.f, 0.f, 0.f, 0.f};
    bf16x8 At[4][2], B0[2][2], B1[2][2];
    const char* cA = (const char*)g.A + (size_t)cur.pm * tstep; const char* cB = (const char*)g.Bt + (size_t)cur.pn * tstep;
    S.a_ready(cur);
    if constexpr (SP2) {
        PG8_STAGE(PG8_SB(0, 0), cB, voffB); PG8_STAGE(PG8_SB(0, 1), cB + hstep, voffB); PG8_STAGE(PG8_SA(0, 0), cA, voffA); PG8_STAGE(PG8_SA(0, 1), cA + hstep, voffA);
        if (wr == 1) PG8_BAR;
        PG8_WAIT_V(2); PG8_BAR;
        PG8_STAGE(PG8_SB(1, 0), cB + kstep, voffB); PG8_STAGE(PG8_SA(1, 0), cA + kstep, voffA); PG8_STAGE(PG8_SB(1, 1), cB + hstep + kstep, voffB);
        PG8_WAIT_V(6); PG8_BAR;
    } else {
        PG8_STAGE(PG8_SB(0, 0), cB, voffB); PG8_STAGE(PG8_SA(0, 0), cA, voffA); PG8_STAGE(PG8_SB(0, 1), cB + hstep, voffB); PG8_STAGE(PG8_SA(0, 1), cA + hstep, voffA);
        if (wr == 1) PG8_BAR;
        PG8_WAIT_V(4); PG8_BAR;
        PG8_STAGE(PG8_SB(1, 0), cB + kstep, voffB); PG8_STAGE(PG8_SA(1, 0), cA + kstep, voffA); PG8_STAGE(PG8_SB(1, 1), cB + hstep + kstep, voffB);
        PG8_WAIT_V(6); PG8_BAR;
    }
    for (;;) {
        const bool has_next = S.next(ui + 1, nxt);
        const char* nA = has_next ? (const char*)g.A + (size_t)nxt.pm * tstep : cA; const char* nB = has_next ? (const char*)g.Bt + (size_t)nxt.pn * tstep : cB;
        for (int t = 0; t < nt; t += 2) {
            const bool last = (t == nt - 2);
            const char* a1 = cA + (size_t)(t + 1) * kstep;
            const char* a2 = last ? nA : cA + (size_t)(t + 2) * kstep; const char* b2 = last ? nB : cB + (size_t)(t + 2) * kstep;
            const char* a3 = a2 + kstep; const char* b3 = b2 + kstep;
            if (last && has_next) S.a_ready(nxt);
            if constexpr (SP2) {
            PG8_LDB(B0, 0, 0); PG8_LDB(B1, 0, 1); PG8_SCHED; PG8_LDA(At, 0, 0); PG8_STAGE(PG8_SA(1, 1), a1 + hstep, voffA);
            PG8_WAIT_V(8); PG8_WAIT_L(0); PG8_BAR; PG8_MMA(0, 0, At, B0); PG8_MMA(0, 1, At, B1); PG8_BAR; PG8_SCHED;
            PG8_LDA(At, 0, 1); PG8_STAGE(PG8_SB(0, 0), b2, voffB); PG8_STAGE(PG8_SB(0, 1), b2 + hstep, voffB); PG8_STAGE(PG8_SA(0, 0), a2, voffA);
            PG8_WAIT_V(8); PG8_WAIT_L(0); PG8_BAR; PG8_MMA(1, 0, At, B0); PG8_MMA(1, 1, At, B1); PG8_BAR; PG8_SCHED;
            PG8_LDB(B0, 1, 0); PG8_LDB(B1, 1, 1); PG8_SCHED; PG8_LDA(At, 1, 0); PG8_STAGE(PG8_SA(0, 1), a2 + hstep, voffA);
            PG8_WAIT_V(8); PG8_WAIT_L(0); PG8_BAR; PG8_MMA(0, 0, At, B0); PG8_MMA(0, 1, At, B1); PG8_BAR; PG8_SCHED;
            PG8_LDA(At, 1, 1); PG8_STAGE(PG8_SB(1, 0), b3, voffB); PG8_STAGE(PG8_SB(1, 1), b3 + hstep, voffB); PG8_STAGE(PG8_SA(1, 0), a3, voffA);
            PG8_WAIT_V(8); PG8_WAIT_L(0); PG8_BAR; PG8_MMA(1, 0, At, B0); PG8_MMA(1, 1, At, B1); PG8_BAR; PG8_SCHED;
            } else {
            PG8_LDB(B0, 0, 0); PG8_SCHED; PG8_LDA(At, 0, 0); PG8_STAGE(PG8_SA(1, 1), a1 + hstep, voffA);
            PG8_WAIT_L(8); PG8_BAR; PG8_WAIT_L(0); PG8_MMA(0, 0, At, B0); PG8_BAR; PG8_SCHED;
            PG8_LDB(B1, 0, 1); PG8_STAGE(PG8_SB(0, 0), b2, voffB);
            PG8_BAR; PG8_WAIT_L(0); PG8_MMA(0, 1, At, B1); PG8_BAR;
            PG8_LDA(At, 0, 1); PG8_STAGE(PG8_SA(0, 0), a2, voffA);
            PG8_BAR; PG8_WAIT_L(0); PG8_MMA(1, 0, At, B0); PG8_BAR; PG8_SCHED;
            PG8_STAGE(PG8_SB(0, 1), b2 + hstep, voffB);
            PG8_WAIT_V(6); PG8_BAR; PG8_MMA(1, 1, At, B1); PG8_BAR;
            PG8_LDB(B0, 1, 0); PG8_SCHED; PG8_LDA(At, 1, 0); PG8_STAGE(PG8_SA(0, 1), a2 + hstep, voffA);
            PG8_WAIT_L(8); PG8_BAR; PG8_WAIT_L(0); PG8_MMA(0, 0, At, B0); PG8_BAR; PG8_SCHED;
            PG8_LDB(B1, 1, 1); PG8_STAGE(PG8_SB(1, 0), b3, voffB);
            PG8_BAR; PG8_WAIT_L(0); PG8_MMA(0, 1, At, B1); PG8_BAR;
            PG8_LDA(At, 1, 1); PG8_STAGE(PG8_SA(1, 0), a3, voffA);
            PG8_BAR; PG8_WAIT_L(0); PG8_MMA(1, 0, At, B0); PG8_BAR; PG8_SCHED;
            PG8_STAGE(PG8_SB(1, 1), b3 + hstep, voffB);
            PG8_WAIT_V(6); PG8_BAR; PG8_MMA(1, 1, At, B1); PG8_BAR;
            }
        }
        if constexpr (ALIGN_EPI) { if (wr == 0) PG8_BAR; }
        if constexpr (!Epi::AFTER_DRAIN) { E(acc, cur, wr, wc, fr, fq); S.done(cur); }
        if (!has_next) break;
#pragma unroll
        for (int a = 0; a < 2; ++a)
#pragma unroll
            for (int b = 0; b < 2; ++b)
#pragma unroll
                for (int m = 0; m < 4; ++m)
#pragma unroll
                    for (int n = 0; n < 2; ++n) acc[a][b][m][n] = (f32x4){0.f, 0.f, 0.f, 0.f};
        cur = nxt; cA = nA; cB = nB; ++ui;
        if constexpr (ALIGN_EPI) { if (wr == 1) PG8_BAR; }
    }
    PG8_WAIT_V(0);
    if constexpr (!ALIGN_EPI) { if (wr == 0) PG8_BAR; }
    PG8_BAR;
    if constexpr (Epi::AFTER_DRAIN) { E.fused(acc, cur, wr, wc, fr, fq, lds, wid, lane); S.done(cur); }
#undef PG8_SA
#undef PG8_SB
#undef PG8_STAGE
#undef PG8_LDA
#undef PG8_LDB
#undef PG8_MMA
#undef PG8_WAIT_V
#undef PG8_WAIT_L
#undef PG8_BAR
#undef PG8_SCHED
}
}

#define DEVI __device__ __forceinline__
#define LAS __attribute__((address_space(3)))
typedef unsigned short bf16_t;
typedef short bf16x8 __attribute__((ext_vector_type(8)));
typedef float f32x4 __attribute__((ext_vector_type(4)));
typedef float f32x16 __attribute__((ext_vector_type(16)));
typedef unsigned u32x4 __attribute__((ext_vector_type(4)));
typedef unsigned u32x2 __attribute__((ext_vector_type(2)));

constexpr int D = 1024, SEQ = 4096, NB = 4, MP = NB * SEQ, NS = 128, FF = 4096;
constexpr float EPS = 1e-6f, LOG2E = 1.4426950408889634f;
constexpr float QSCALE = 0.125f * 1.4426950408889634f;
constexpr int NWAVES = 8;
constexpr int LDS_BYTES = 131072 + 1024;

constexpr size_t O_YP = 0, O_YS = 16777216, O_SPRE = 16908288, O_SPIM = 16941056, O_KP = 16973824, O_VP = 17104896,
                 O_SSRE = 17235968, O_SSIM = 18284544, O_KS = 19333120, O_VS = 23527424;
constexpr size_t MiB = 1u << 20, KiB = 1024;
constexpr size_t WS_WGLU = 1 * MiB, WS_WQKV = 9 * MiB, WS_WQ1 = 12 * MiB, WS_WO = 14 * MiB, WS_WIN = 18 * MiB, WS_WOUT = 50 * MiB;
constexpr size_t WS_LAM = 82 * MiB, WS_BBAR = WS_LAM + 64 * KiB, WS_CMAT = WS_BBAR + 512 * KiB, WS_ROPE = WS_CMAT + 512 * KiB;
constexpr size_t WS_SS = 84 * MiB + 512 * KiB;
constexpr size_t WS_GS = 85 * MiB, WS_QS = WS_GS + 512 * KiB, WS_OS = WS_QS + 512 * KiB, WS_HS = WS_OS + 512 * KiB;
constexpr size_t WS_XB = 89 * MiB, WS_K = 121 * MiB, WS_V = 129 * MiB, WS_H = 137 * MiB;
constexpr size_t WS_G = WS_H, WS_Q = WS_H, WS_O = WS_H + 32 * MiB, WS_E = WS_H + 64 * MiB;
constexpr size_t WS_PS = 265 * MiB;
constexpr size_t WS_END = 267 * MiB;
static_assert(WS_ROPE + 4097 * 64 * 4 <= WS_SS, "tables");

DEVI unsigned pkbf(float lo, float hi) { unsigned r; asm volatile("v_cvt_pk_bf16_f32 %0, %1, %2" : "=v"(r) : "v"(lo), "v"(hi)); return r; }
DEVI float wave_sum(float v) {
#pragma unroll
    for (int o = 1; o < 64; o <<= 1) v += __shfl_xor(v, o);
    return v;
}
DEVI float wave_max(float v) {
#pragma unroll
    for (int o = 1; o < 64; o <<= 1) v = fmaxf(v, __shfl_xor(v, o));
    return v;
}
DEVI void sincos_ang(float ang, float& s, float& c) {
    double t = (double)ang * 0.15915494309189535; t -= floor(t); const float f = (float)t;
    s = __builtin_amdgcn_sinf(f); c = __builtin_amdgcn_cosf(f);
}
DEVI float gelu_tanh(float y) {
    const float z2 = 1.5957691216057308f * (y + 0.044715f * y * y * y);
    return y * __builtin_amdgcn_rcpf(1.0f + __expf(-z2));
}
DEVI float sigmoidf_(float g) { return __builtin_amdgcn_rcpf(1.0f + __expf(-g)); }
constexpr int PT_OFF = 131072;
DEVI unsigned long long ldp_raw(int k) {
    unsigned long long v; const unsigned addr = PT_OFF + 8 * k;
    asm volatile("ds_read_b64 %0, %1\n\ts_waitcnt lgkmcnt(0)" : "=v"(v) : "v"(addr) : "memory");
    const unsigned lo = __builtin_amdgcn_readfirstlane((unsigned)v), hi = __builtin_amdgcn_readfirstlane((unsigned)(v >> 32));
    return ((unsigned long long)hi << 32) | lo;
}
#define GAS1 __attribute__((address_space(1)))
#define PIN(k) ((const float*)(const GAS1 float*)ldp_raw(k))
#define POUT() ((float*)(GAS1 float*)ldp_raw(28))
#define PWS() ((unsigned char*)(GAS1 unsigned char*)ldp_raw(29))

template <int NV> DEVI float row_ss(const float* ps, int row) {
    float s = 0.f;
#pragma unroll
    for (int i = 0; i < NV; ++i) { const f32x4 v = *(const f32x4*)(ps + (size_t)row * 32 + 4 * i); s += (v[0] + v[1]) + (v[2] + v[3]); }
    return s;
}
template <int NV> DEVI void row_ld(f32x4 (&pf)[NV], const float* ps, int row) {
#pragma unroll
    for (int i = 0; i < NV; ++i) pf[i] = *(const f32x4*)(ps + (size_t)row * 32 + 4 * i);
}
template <int NV> DEVI float row_sum(const f32x4 (&pf)[NV]) {
    float s = 0.f;
#pragma unroll
    for (int i = 0; i < NV; ++i) s += (pf[i][0] + pf[i][1]) + (pf[i][2] + pf[i][3]);
    return s;
}
DEVI float row_ss_rt(const float* ps, size_t row, int nv) {
    float s = 0.f;
    for (int i = 0; i < nv; ++i) { const f32x4 v = *(const f32x4*)(ps + row * 32 + 4 * i); s += (v[0] + v[1]) + (v[2] + v[3]); }
    return s;
}
#define WT_STORE16(w, rsrc, off) __builtin_amdgcn_raw_buffer_store_b128((w), (rsrc), (unsigned)(off), 0, 16)
namespace pg8 {
typedef unsigned u32x2 __attribute__((ext_vector_type(2)));
DEVI f32x4 bf4_to_f32(u32x2 w) { f32x4 r; r[0] = __uint_as_float(w.x << 16); r[1] = __uint_as_float(w.x & 0xffff0000u); r[2] = __uint_as_float(w.y << 16); r[3] = __uint_as_float(w.y & 0xffff0000u); return r; }
struct EpiResid {
    static constexpr bool PERM = true, AFTER_DRAIN = false;
    bf16_t* xb; float* outf; float* ss;
    __device__ __forceinline__ void operator()(const f32x4 (&acc)[2][2][4][2], const Unit& u, int wr, int wc, int fr, int fq) const {
        const int col0 = u.pn * BM + wc * 32 + 8 * fq;
        u32x4 pb[2];
#pragma unroll
        for (int bj = 0; bj < 2; ++bj) pb[bj] = *(const u32x4*)(xb + (size_t)(u.pm * BM + wr * 64 + fr) * 1024 + col0 + bj * HALF);
#pragma unroll
        for (int ai = 0; ai < 2; ++ai)
#pragma unroll
            for (int m = 0; m < 4; ++m) {
                const int row = u.pm * BM + ai * HALF + wr * 64 + m * 16 + fr;
                const size_t off = (size_t)row * 1024 + col0;
                const u32x4 cb0 = pb[0], cb1 = pb[1];
                if (ai * 4 + m < 7) { const int t1 = ai * 4 + m + 1; const size_t o1 = (size_t)(u.pm * BM + (t1 >> 2) * HALF + wr * 64 + (t1 & 3) * 16 + fr) * 1024 + col0;
#pragma unroll
                    for (int bj = 0; bj < 2; ++bj) pb[bj] = *(const u32x4*)(xb + o1 + bj * HALF); }
                asm volatile("" ::: "memory");
                float s = 0.f;
#pragma unroll
                for (int bj = 0; bj < 2; ++bj) {
                    const u32x4 cb = bj ? cb1 : cb0;
                    const size_t o = off + bj * HALF;
                    const f32x4 v0 = bf4_to_f32((u32x2){cb.x, cb.y}) + acc[ai][bj][m][0], v1 = bf4_to_f32((u32x2){cb.z, cb.w}) + acc[ai][bj][m][1];
                    if (outf) { *(f32x4*)(outf + o) = v0; *(f32x4*)(outf + o + 4) = v1; }
                    else { u32x4 w; w.x = cvt_pk_bf16(v0[0], v0[1]); w.y = cvt_pk_bf16(v0[2], v0[3]); w.z = cvt_pk_bf16(v1[0], v1[1]); w.w = cvt_pk_bf16(v1[2], v1[3]); *(u32x4*)(xb + o) = w; }
                    s += ((v0[0] * v0[0] + v0[1] * v0[1]) + (v0[2] * v0[2] + v0[3] * v0[3])) + ((v1[0] * v1[0] + v1[1] * v1[1]) + (v1[2] * v1[2] + v1[3] * v1[3]));
                }
                if (ss) { s += __shfl_xor(s, 16); s += __shfl_xor(s, 32); if (fq == 0) ss[(size_t)row * 32 + u.pn * 4 + wc] = s; }
                asm volatile("" ::: "memory");
            }
    }
};
struct EpiGlu {
    static constexpr bool PERM = true, AFTER_DRAIN = false;
    bf16_t* xb; float* ss; const float* bias;
    __device__ __forceinline__ void operator()(const f32x4 (&acc)[2][2][4][2], const Unit& u, int wr, int wc, int fr, int fq) const {
        const int c0 = u.pn * 128 + wc * 32 + 8 * fq;
        f32x4 bv[2], bg[2];
#pragma unroll
        for (int n = 0; n < 2; ++n) { bv[n] = *(const f32x4*)(bias + c0 + 4 * n); bg[n] = *(const f32x4*)(bias + 1024 + c0 + 4 * n); }
        u32x4 pb = *(const u32x4*)(xb + (size_t)(u.pm * BM + wr * 64 + fr) * 1024 + c0);
#pragma unroll
        for (int ai = 0; ai < 2; ++ai)
#pragma unroll
            for (int m = 0; m < 4; ++m) {
                const int row = u.pm * BM + ai * HALF + wr * 64 + m * 16 + fr;
                const u32x4 cb = pb;
                if (ai * 4 + m < 7) { const int t1 = ai * 4 + m + 1; pb = *(const u32x4*)(xb + (size_t)(u.pm * BM + (t1 >> 2) * HALF + wr * 64 + (t1 & 3) * 16 + fr) * 1024 + c0); }
                asm volatile("" ::: "memory");
                const size_t o = (size_t)row * 1024 + c0;
                f32x4 v[2] = {bf4_to_f32((u32x2){cb.x, cb.y}), bf4_to_f32((u32x2){cb.z, cb.w})};
                float s = 0.f;
#pragma unroll
                for (int n = 0; n < 2; ++n) {
                    const f32x4 val = acc[ai][0][m][n] + bv[n], gt = acc[ai][1][m][n] + bg[n];
#pragma unroll
                    for (int e = 0; e < 4; ++e) v[n][e] += val[e] * __builtin_amdgcn_rcpf(1.0f + __expf(-gt[e]));
                    s += (v[n][0] * v[n][0] + v[n][1] * v[n][1]) + (v[n][2] * v[n][2] + v[n][3] * v[n][3]);
                }
                u32x4 w; w.x = cvt_pk_bf16(v[0][0], v[0][1]); w.y = cvt_pk_bf16(v[0][2], v[0][3]); w.z = cvt_pk_bf16(v[1][0], v[1][1]); w.w = cvt_pk_bf16(v[1][2], v[1][3]);
                *(u32x4*)(xb + o) = w;
                s += __shfl_xor(s, 16); s += __shfl_xor(s, 32); if (fq == 0) ss[(size_t)row * 32 + u.pn * 4 + wc] = s;
                asm volatile("" ::: "memory");
            }
    }
};
template <int NV> struct EpiMlpIn {
    static constexpr bool PERM = true, AFTER_DRAIN = false;
    bf16_t* H; const float* ss; __amdgpu_buffer_rsrc_t wsr;
    __device__ __forceinline__ void operator()(const f32x4 (&acc)[2][2][4][2], const Unit& u, int wr, int wc, int fr, int fq) const {
        const int col0 = u.pn * BM + wc * 32 + 8 * fq;
        f32x4 pf[NV]; row_ld<NV>(pf, ss, u.pm * BM + wr * 64 + fr);
#pragma unroll
        for (int ai = 0; ai < 2; ++ai)
#pragma unroll
            for (int m = 0; m < 4; ++m) {
                const int row = u.pm * BM + ai * HALF + wr * 64 + m * 16 + fr;
                const float rs = rsqrtf(row_sum<NV>(pf) * (1.0f / 1024.0f) + 1e-6f);
                if (ai * 4 + m < 7) { const int t1 = ai * 4 + m + 1; row_ld<NV>(pf, ss, u.pm * BM + (t1 >> 2) * HALF + wr * 64 + (t1 & 3) * 16 + fr); }
                asm volatile("" ::: "memory");
                bf16_t* rowp = H + (size_t)row * 4096 + col0;
#pragma unroll
                for (int bj = 0; bj < 2; ++bj) {
                    f32x4 v0 = acc[ai][bj][m][0] * rs, v1 = acc[ai][bj][m][1] * rs;
#pragma unroll
                    for (int e = 0; e < 4; ++e) { const float a = fmaxf(v0[e], 0.f), b = fmaxf(v1[e], 0.f); v0[e] = a * a; v1[e] = b * b; }
                    u32x4 w; w.x = cvt_pk_bf16(v0[0], v0[1]); w.y = cvt_pk_bf16(v0[2], v0[3]); w.z = cvt_pk_bf16(v1[0], v1[1]); w.w = cvt_pk_bf16(v1[2], v1[3]);
                    WT_STORE16(w, wsr, WS_H + ((size_t)row * 4096 + col0 + bj * HALF) * 2);
                }
                asm volatile("" ::: "memory");
            }
    }
};
struct EpiQKV {
    static constexpr bool PERM = true, AFTER_DRAIN = false;
    bf16_t *Q, *Kb, *Vb; const float* ss; const float* qg; const float* kg; const float* rope; float* outk; float* outv; int nq;
    __device__ __forceinline__ void operator()(const f32x4 (&acc)[2][2][4][2], const Unit& u, int wr, int wc, int fr, int fq) const {
        const int d0 = 8 * fq;
        if (u.pn <= nq) {
            const bool isq = u.pn < nq; const float* gn = isq ? qg : kg; const float sc = isq ? (0.125f * 1.4426950408889634f) : 1.0f;
            f32x4 g[2][2];
#pragma unroll
            for (int bj = 0; bj < 2; ++bj)
#pragma unroll
                for (int n = 0; n < 2; ++n) g[bj][n] = *(const f32x4*)(gn + 32 * bj + d0 + 4 * n) * sc;
            f32x4 pf[4]; row_ld<4>(pf, ss, u.pm * BM + wr * 64 + fr);
#pragma unroll
            for (int ai = 0; ai < 2; ++ai)
#pragma unroll
                for (int m = 0; m < 4; ++m) {
                    const int row = u.pm * BM + ai * HALF + wr * 64 + m * 16 + fr;
                    const float rs = rsqrtf(row_sum<4>(pf) * (1.0f / 1024.0f) + 1e-6f);
                    if (ai * 4 + m < 7) { const int t1 = ai * 4 + m + 1; row_ld<4>(pf, ss, u.pm * BM + (t1 >> 2) * HALF + wr * 64 + (t1 & 3) * 16 + fr); }
                    asm volatile("" ::: "memory");
                    const int pos = row & 4095;
                    f32x4 v[2][2]; float s = 0.f;
#pragma unroll
                    for (int bj = 0; bj < 2; ++bj)
#pragma unroll
                        for (int n = 0; n < 2; ++n) { v[bj][n] = acc[ai][bj][m][n] * rs; s += (v[bj][n][0] * v[bj][n][0] + v[bj][n][1] * v[bj][n][1]) + (v[bj][n][2] * v[bj][n][2] + v[bj][n][3] * v[bj][n][3]); }
                    s += __shfl_xor(s, 16); s += __shfl_xor(s, 32);
                    const float rn = rsqrtf(s * (1.0f / 64.0f) + 1e-6f);
                    f32x4 lo[2], hi[2];
#pragma unroll
                    for (int n = 0; n < 2; ++n) {
                        const f32x4 cs = *(const f32x4*)(rope + (size_t)pos * 64 + d0 + 4 * n), sn = *(const f32x4*)(rope + (size_t)pos * 64 + 32 + d0 + 4 * n);
                        const f32x4 x1 = v[0][n] * rn * g[0][n], x2 = v[1][n] * rn * g[1][n];
                        lo[n] = x1 * cs - x2 * sn; hi[n] = x2 * cs + x1 * sn;
                    }
                    bf16_t* dst = isq ? (Q + (size_t)row * 1024 + (4 * u.pn + wc) * 64 + d0) : (Kb + (size_t)row * 256 + wc * 64 + d0);
                    u32x4 w; w.x = cvt_pk_bf16(lo[0][0], lo[0][1]); w.y = cvt_pk_bf16(lo[0][2], lo[0][3]); w.z = cvt_pk_bf16(lo[1][0], lo[1][1]); w.w = cvt_pk_bf16(lo[1][2], lo[1][3]);
                    *(u32x4*)dst = w;
                    w.x = cvt_pk_bf16(hi[0][0], hi[0][1]); w.y = cvt_pk_bf16(hi[0][2], hi[0][3]); w.z = cvt_pk_bf16(hi[1][0], hi[1][1]); w.w = cvt_pk_bf16(hi[1][2], hi[1][3]);
                    *(u32x4*)(dst + 32) = w;
                    if (!isq && pos >= 3968) {
                        float* ok = outk + ((size_t)((row >> 12) * 128 + (pos - 3968)) * 4 + wc) * 64 + d0;
                        *(f32x4*)ok = lo[0]; *(f32x4*)(ok + 4) = lo[1]; *(f32x4*)(ok + 32) = hi[0]; *(f32x4*)(ok + 36) = hi[1];
                    }
                    asm volatile("" ::: "memory");
                }
        } else {
            const int col0 = wc * 32 + 8 * fq;
            f32x4 pf[4]; row_ld<4>(pf, ss, u.pm * BM + wr * 64 + fr);
#pragma unroll
            for (int ai = 0; ai < 2; ++ai)
#pragma unroll
                for (int m = 0; m < 4; ++m) {
                    const int row = u.pm * BM + ai * HALF + wr * 64 + m * 16 + fr;
                    const float rs = rsqrtf(row_sum<4>(pf) * (1.0f / 1024.0f) + 1e-6f);
                    if (ai * 4 + m < 7) { const int t1 = ai * 4 + m + 1; row_ld<4>(pf, ss, u.pm * BM + (t1 >> 2) * HALF + wr * 64 + (t1 & 3) * 16 + fr); }
                    asm volatile("" ::: "memory");
                    const int pos = row & 4095;
#pragma unroll
                    for (int bj = 0; bj < 2; ++bj) {
                        const f32x4 v0 = acc[ai][bj][m][0] * rs, v1 = acc[ai][bj][m][1] * rs;
                        u32x4 w; w.x = cvt_pk_bf16(v0[0], v0[1]); w.y = cvt_pk_bf16(v0[2], v0[3]); w.z = cvt_pk_bf16(v1[0], v1[1]); w.w = cvt_pk_bf16(v1[2], v1[3]);
                        *(u32x4*)(Vb + (size_t)row * 256 + bj * HALF + col0) = w;
                        if (pos >= 3968) { float* ov = outv + (size_t)((row >> 12) * 128 + (pos - 3968)) * 256 + bj * HALF + col0; *(f32x4*)ov = v0; *(f32x4*)(ov + 4) = v1; }
                    }
                    asm volatile("" ::: "memory");
                }
        }
    }
};
}

DEVI unsigned f2bf(float f) { unsigned u = __builtin_bit_cast(unsigned, f); return (u + 0x7fffu + ((u >> 16) & 1u)) >> 16; }
DEVI unsigned pk2(float lo, float hi) { return f2bf(lo) | (f2bf(hi) << 16); }
DEVI int wt_row(int mode, int c) {
    if (mode == 1) { return c < 1024 ? (256 * (c >> 7) + (c & 127)) : (256 * ((c - 1024) >> 7) + 128 + (c & 127)); }
    if (mode == 2) { const int hd = c >> 6, dd = c & 32; return 256 * (hd >> 2) + 4 * dd + 32 * (hd & 3); }
    return c;
}
DEVI void transpose_item(const float* W, int K, int N, bf16_t* WT, int row_off, int mode, const float* gain, LAS float* scr, int item, int lane) {
    const int nblk = N / 32, kb = item / nblk, nb = item % nblk, k0 = 64 * kb, n0 = 32 * nb;
    f32x4 wv[8];
#pragma unroll
    for (int i = 0; i < 8; ++i) wv[i] = *(const f32x4*)(W + (size_t)(k0 + 8 * i + (lane >> 3)) * N + n0 + 4 * (lane & 7));
#pragma unroll
    for (int i = 0; i < 8; ++i) { const int kk = 8 * i + (lane >> 3); const float gk = gain ? gain[k0 + kk] : 1.0f; LAS float* d = scr + kk * 33 + 4 * (lane & 7);
        d[0] = wv[i][0] * gk; d[1] = wv[i][1] * gk; d[2] = wv[i][2] * gk; d[3] = wv[i][3] * gk; }
    asm volatile("s_waitcnt lgkmcnt(0)" ::: "memory");
    const int c = lane & 7; const int rb = row_off + wt_row(mode, n0);
#pragma unroll
    for (int j = 0; j < 4; ++j) { const int n = (lane >> 3) + 8 * j; const LAS float* s = scr + (8 * c) * 33 + n;
        u32x4 o; o.x = pk2(s[0 * 33], s[1 * 33]); o.y = pk2(s[2 * 33], s[3 * 33]); o.z = pk2(s[4 * 33], s[5 * 33]); o.w = pk2(s[6 * 33], s[7 * 33]);
        *(u32x4*)(WT + (size_t)(rb + n) * K + k0 + 8 * c) = o; }
    asm volatile("s_waitcnt lgkmcnt(0)" ::: "memory");
}

DEVI void cache_copy(const float* ck, const float* cv, float* out, int first, int nthr) {
    for (int i0 = first; i0 < NS * 127 * 64; i0 += 4 * nthr) {
        f32x4 kv4[4], vv4[4]; size_t dst[4];
#pragma unroll
        for (int t = 0; t < 4; ++t) { const int i = i0 + t * nthr; const bool ok = i < NS * 127 * 64; const int ii = ok ? i : 0; const int b = ii / (127 * 64), rem = ii % (127 * 64);
            dst[t] = ok ? ((size_t)b * 128 * 64 + rem) : (size_t)-1;
            kv4[t] = ((const f32x4*)ck)[(size_t)b * 128 * 64 + 64 + rem]; vv4[t] = ((const f32x4*)cv)[(size_t)b * 128 * 64 + 64 + rem]; }
#pragma unroll
        for (int t = 0; t < 4; ++t) if (dst[t] != (size_t)-1) { ((f32x4*)(out + O_KS))[dst[t]] = kv4[t]; ((f32x4*)(out + O_VS))[dst[t]] = vv4[t]; }
    }
}

struct Args { const float* in[28]; float* out; unsigned char* ws; float inv[32]; int ph_lo, ph_hi; };

DEVI void prologue(const Args& a, LAS unsigned char* lds, int vcu, int G, int tid, int wave, int lane) {
    unsigned char* ws = a.ws;
    LAS float* scr = (LAS float*)(lds + wave * 16384);
    const int gw = vcu * NWAVES + wave, NGW = G * NWAVES;
    constexpr int I_GLU = 16 * 64, I_Q = 16 * 32, I_KV = 16 * 8, I_O = 16 * 32, I_IN = 16 * 128, I_OUT = 64 * 32;
    constexpr int NITEMS = 2 * I_GLU + 2 * I_Q + 2 * I_KV + 2 * I_O + 4 * I_IN + 4 * I_OUT;
    const float* nmix = a.in[6]; const float* nmlp = a.in[7]; const float* nkv = a.in[18];
    for (int it = gw; it < NITEMS; it += NGW) {
        int r = it;
        if (r < 2 * I_GLU) { const int l = r / I_GLU; transpose_item(a.in[16] + (size_t)l * 1024 * 2048, 1024, 2048, (bf16_t*)(ws + WS_WGLU) + (size_t)l * 2048 * 1024, 0, 1, nullptr, scr, r % I_GLU, lane); continue; } r -= 2 * I_GLU;
        if (r < I_Q) { transpose_item(a.in[22], 1024, 1024, (bf16_t*)(ws + WS_WQKV), 0, 2, nmix + 2 * 1024, scr, r, lane); continue; } r -= I_Q;
        if (r < I_Q) { transpose_item(a.in[22] + 1024 * 1024, 1024, 1024, (bf16_t*)(ws + WS_WQ1), 0, 2, nmix + 3 * 1024, scr, r, lane); continue; } r -= I_Q;
        if (r < I_KV) { transpose_item(a.in[19], 1024, 256, (bf16_t*)(ws + WS_WQKV), 1024, 2, nkv, scr, r, lane); continue; } r -= I_KV;
        if (r < I_KV) { transpose_item(a.in[20], 1024, 256, (bf16_t*)(ws + WS_WQKV), 1280, 0, nkv, scr, r, lane); continue; } r -= I_KV;
        if (r < 2 * I_O) { const int l = r / I_O; transpose_item(a.in[25] + (size_t)l * 1024 * 1024, 1024, 1024, (bf16_t*)(ws + WS_WO) + (size_t)l * 1024 * 1024, 0, 0, nullptr, scr, r % I_O, lane); continue; } r -= 2 * I_O;
        if (r < 4 * I_IN) { const int l = r / I_IN; transpose_item(a.in[26] + (size_t)l * 1024 * 4096, 1024, 4096, (bf16_t*)(ws + WS_WIN) + (size_t)l * 4096 * 1024, 0, 0, nmlp + l * 1024, scr, r % I_IN, lane); continue; } r -= 4 * I_IN;
        { const int l = r / I_OUT; transpose_item(a.in[27] + (size_t)l * 4096 * 1024, 4096, 1024, (bf16_t*)(ws + WS_WOUT) + (size_t)l * 1024 * 4096, 0, 0, nullptr, scr, r % I_OUT, lane); }
    }
    float* PS = (float*)(ws + WS_PS);
    for (int m0 = 4 * gw; m0 < MP; m0 += 4 * NGW) {
        f32x4 xv[4][4];
#pragma unroll
        for (int rr = 0; rr < 4; ++rr)
#pragma unroll
            for (int j = 0; j < 4; ++j) xv[rr][j] = ((const f32x4*)(a.in[0] + (size_t)(m0 + rr) * 1024) + lane)[64 * j];
#pragma unroll
        for (int rr = 0; rr < 4; ++rr) { const int m = m0 + rr; float s = 0.f;
#pragma unroll
            for (int j = 0; j < 4; ++j) { const f32x4 v = xv[rr][j]; s += (v[0] * v[0] + v[1] * v[1]) + (v[2] * v[2] + v[3] * v[3]);
                u32x2 w; w.x = pkbf(v[0], v[1]); w.y = pkbf(v[2], v[3]); *(u32x2*)((bf16_t*)(ws + WS_XB) + (size_t)m * 1024 + 4 * lane + 256 * j) = w; }
            s = wave_sum(s); if (lane < 4) *(f32x4*)(PS + (size_t)m * 32 + 4 * lane) = (f32x4){lane == 0 ? s : 0.f, 0.f, 0.f, 0.f}; }
    }
    const int gt = vcu * 512 + tid, NT = G * 512;
    for (int i = gt; i < NS * 1024 / 4; i += NT) ((f32x4*)(a.out + O_YS))[i] = ((const f32x4*)a.in[1])[i];
    if (MULTI || G != 256) cache_copy(a.in[4], a.in[5], a.out, gt, NT);
    float* rope = (float*)(ws + WS_ROPE);
    for (int i = gt; i < 4097 * 32; i += NT) { const int pr = i >> 5, d = i & 31; const float pos = (pr == 4096) ? 8192.f : (float)pr; const float ang = pos * a.inv[d];
        float s, c; sincos_ang(ang, s, c); rope[(size_t)pr * 64 + d] = c; rope[(size_t)pr * 64 + 32 + d] = s; }
    float* LAM = (float*)(ws + WS_LAM); bf16_t* BBAR = (bf16_t*)(ws + WS_BBAR); bf16_t* CMAT = (bf16_t*)(ws + WS_CMAT);
    for (int q = gt; q < 2 * 64 * 64 * 16; q += NT) {
        const int c = q & 15, i = q >> 4, p = i & 63, lg = i >> 6;
        const float dt = expf(a.in[10][i]), are = a.in[8][i], aim = a.in[9][i];
        const float mag = expf(are * dt); float sn, cs; sincos_ang(aim * dt, sn, cs);
        const float lbr = mag * cs, lbi = mag * sn;
        if (c == 0) { LAM[2 * i] = lbr; LAM[2 * i + 1] = lbi; }
        const float den = 1.0f / (are * are + aim * aim);
        const float cr = ((lbr - 1.f) * are + lbi * aim) * den, ci = (lbi * are - (lbr - 1.f) * aim) * den;
        const float br = a.in[11][(size_t)i * 16 + c], bi = a.in[12][(size_t)i * 16 + c];
        BBAR[((size_t)(lg * 2 + 0) * 64 + p) * 16 + c] = (bf16_t)f2bf(cr * br - ci * bi);
        BBAR[((size_t)(lg * 2 + 1) * 64 + p) * 16 + c] = (bf16_t)f2bf(cr * bi + ci * br);
        CMAT[((size_t)lg * 16 + c) * 128 + 2 * p] = (bf16_t)f2bf(a.in[13][((size_t)lg * 16 + c) * 64 + p]);
        CMAT[((size_t)lg * 16 + c) * 128 + 2 * p + 1] = (bf16_t)f2bf(-a.in[14][((size_t)lg * 16 + c) * 64 + p]);
    }
}

DEVI f32x4 bf4_to_f32(u32x2 w) { f32x4 r; r[0] = __uint_as_float(w.x << 16); r[1] = __uint_as_float(w.x & 0xffff0000u); r[2] = __uint_as_float(w.y << 16); r[3] = __uint_as_float(w.y & 0xffff0000u); return r; }
#define MFMA32(a, b, c) __builtin_amdgcn_mfma_f32_32x32x16_bf16((a), (b), (c), 0, 0, 0)
#define MFMA16(a, b, c) __builtin_amdgcn_mfma_f32_16x16x32_bf16((a), (b), (c), 0, 0, 0)
template <bool P2>
DEVI void s5_pass(LAS unsigned char* lds, int layer, const bf16_t* x, const float* ss, const float* gain, const float* dsk, const unsigned char* ws_c, unsigned char* ws,
                  float* out_re, float* out_im, int vcu, int G, int tid, int wave, int lane) {
    const float* LAM = (const float*)(ws_c + WS_LAM); const bf16_t* BBAR = (const bf16_t*)(ws_c + WS_BBAR); const bf16_t* CMAT = (const bf16_t*)(ws_c + WS_CMAT);
    float* E = (float*)(ws + WS_E); bf16_t* Gout = (bf16_t*)(ws + WS_G);
    const int r = lane & 31, h = lane >> 5;
    LAS unsigned char* lw = lds + wave * 10752;
    LAS float* rsb = (LAS float*)(lds + 8 * 10752);
    for (int it = vcu; it < 512; it += G) {
        const int gblk = it & 7, pair = (it >> 3) & 15, b = it >> 7;
        const int g = gblk * 8 + wave, lg = layer * 64 + g;
        const int hsel = (r >> 2) & 1, ti = (r & 3) + 4 * (r >> 3);
        const size_t tokA0 = (size_t)b * 4096 + (pair + 16 * hsel) * 128 + ti;
        __syncthreads();
        if (tid < 256) { const int tk = b * 4096 + (pair + 16 * (tid >> 7)) * 128 + (tid & 127); rsb[tid] = rsqrtf(row_ss<4>(ss, tk) * (1.0f / 1024.0f) + EPS); }
        u32x4 xw[8];
#pragma unroll
        for (int iter = 0; iter < 8; ++iter) xw[iter] = *(const u32x4*)(x + (tokA0 + 16 * iter) * 1024 + 16 * g + 8 * h);
        float gn[8];
#pragma unroll
        for (int jx = 0; jx < 8; ++jx) gn[jx] = gain[16 * g + 8 * h + jx];
        bf16x8 bb[2][2];
#pragma unroll
        for (int pt = 0; pt < 2; ++pt)
#pragma unroll
            for (int xx = 0; xx < 2; ++xx) bb[pt][xx] = *(const bf16x8*)(BBAR + ((size_t)(lg * 2 + xx) * 64 + 32 * pt + r) * 16 + 8 * h);
        float lr[2], li[2], sr[2] = {0.f, 0.f}, si[2] = {0.f, 0.f};
#pragma unroll
        for (int pt = 0; pt < 2; ++pt) { lr[pt] = LAM[2 * (lg * 64 + 32 * pt + r)]; li[pt] = LAM[2 * (lg * 64 + 32 * pt + r) + 1]; }
        const int ck = pair + 16 * h;
        bf16x8 cm[4]; float gc = 0.f, dc = 0.f;
        if (P2) {
#pragma unroll
            for (int ks = 0; ks < 4; ++ks) cm[ks] = *(const bf16x8*)(CMAT + ((size_t)lg * 16 + (lane & 15)) * 128 + 32 * ks + 8 * (lane >> 4));
            dc = dsk[16 * g + (lane & 15)];
            float ar[2], ai[2];
#pragma unroll
            for (int pt = 0; pt < 2; ++pt) { ar[pt] = lr[pt]; ai[pt] = li[pt];
#pragma unroll
                for (int q = 0; q < 7; ++q) { const float nr = ar[pt] * ar[pt] - ai[pt] * ai[pt], ni = 2.f * ar[pt] * ai[pt]; ar[pt] = nr; ai[pt] = ni; } }
            float er[31][2], ei[31][2];
#pragma unroll
            for (int jx = 0; jx < 31; ++jx)
#pragma unroll
                for (int pt = 0; pt < 2; ++pt) { const float* e = E + ((size_t)((b * 32 + jx) * 64 + g) * 64 + 32 * pt + r) * 2; er[jx][pt] = e[0]; ei[jx][pt] = e[1]; }
#pragma unroll
            for (int jx = 0; jx < 31; ++jx)
#pragma unroll
                for (int pt = 0; pt < 2; ++pt) {
                    const float nr = ar[pt] * sr[pt] - ai[pt] * si[pt] + er[jx][pt], ni = ar[pt] * si[pt] + ai[pt] * sr[pt] + ei[jx][pt];
                    if (jx < ck) { sr[pt] = nr; si[pt] = ni; }
                }
        }
        __syncthreads();
#pragma unroll
        for (int iter = 0; iter < 8; ++iter) {
            const f32x4 x0 = bf4_to_f32((u32x2){xw[iter].x, xw[iter].y}), x1 = bf4_to_f32((u32x2){xw[iter].z, xw[iter].w});
            const float rs = rsb[128 * hsel + 16 * iter + ti];
            float u[8];
#pragma unroll
            for (int jx = 0; jx < 4; ++jx) { u[jx] = x0[jx] * rs * gn[jx]; u[4 + jx] = x1[jx] * rs * gn[4 + jx]; }
            u32x4 au; au.x = pkbf(u[0], u[1]); au.y = pkbf(u[2], u[3]); au.z = pkbf(u[4], u[5]); au.w = pkbf(u[6], u[7]);
            const bf16x8 af = __builtin_bit_cast(bf16x8, au);
            f32x16 acc[2][2];
#pragma unroll
            for (int pt = 0; pt < 2; ++pt)
#pragma unroll
                for (int xx = 0; xx < 2; ++xx) { f32x16 z = {}; acc[pt][xx] = MFMA32(af, bb[pt][xx], z); }
#pragma unroll
            for (int pt = 0; pt < 2; ++pt)
#pragma unroll
                for (int i = 0; i < 16; ++i) {
                    const float nr = __builtin_fmaf(lr[pt], sr[pt], __builtin_fmaf(-li[pt], si[pt], acc[pt][0][i])), ni = __builtin_fmaf(lr[pt], si[pt], __builtin_fmaf(li[pt], sr[pt], acc[pt][1][i]));
                    sr[pt] = nr; si[pt] = ni; acc[pt][0][i] = nr; acc[pt][1][i] = ni;
                }
            if (P2) {
                asm volatile("" ::: "memory");
                { LAS f32x4* up = (LAS f32x4*)(lw + 8704 + (16 * hsel + ti) * 64 + 32 * h); up[0] = (f32x4){u[0], u[1], u[2], u[3]}; up[1] = (f32x4){u[4], u[5], u[6], u[7]}; }
#pragma unroll
                for (int pt = 0; pt < 2; ++pt)
#pragma unroll
                    for (int i = 0; i < 16; ++i) *(LAS unsigned*)(lw + (16 * h + i) * 272 + 4 * (32 * pt + r)) = pkbf(acc[pt][0][i], acc[pt][1][i]);
                asm volatile("" ::: "memory");
#pragma unroll
                for (int mt = 0; mt < 2; ++mt) {
                    f32x4 y = {0.f, 0.f, 0.f, 0.f};
#pragma unroll
                    for (int ks = 0; ks < 4; ++ks) { const bf16x8 sa = *(const LAS bf16x8*)(lw + (16 * mt + (lane & 15)) * 272 + 64 * ks + 16 * (lane >> 4)); y = MFMA16(sa, cm[ks], y); }
                    const int c = lane & 15;
#pragma unroll
                    for (int q = 0; q < 4; ++q) {
                        const size_t t2 = (size_t)b * 4096 + (pair + 16 * mt) * 128 + 16 * iter + 4 * (lane >> 4) + q;
                        const float uu = *(const LAS float*)(lw + 8704 + (16 * mt + 4 * (lane >> 4) + q) * 64 + 4 * c);
                        const float yy = y[q] + dc * uu;
                        Gout[t2 * 1024 + 16 * g + c] = (bf16_t)(pkbf(gelu_tanh(yy), 0.f) & 0xffffu);
                    }
                }
                asm volatile("" ::: "memory");
            }
        }
        if (!P2) {
#pragma unroll
            for (int pt = 0; pt < 2; ++pt) { float* e = E + ((size_t)((b * 32 + ck) * 64 + g) * 64 + 32 * pt + r) * 2; e[0] = sr[pt]; e[1] = si[pt]; }
        } else if (ck == 31) {
#pragma unroll
            for (int pt = 0; pt < 2; ++pt) { const size_t o = (size_t)((layer * 4 + b) * 64 + g) * 64 + 32 * pt + r; out_re[o] = sr[pt]; out_im[o] = si[pt]; }
        }
        (void)gc;
    }
    __syncthreads();
}

DEVI void s5_sample(int layer, float* xs, float* gs, int gw, int NGW, int lane) {
    const float* const in6 = PIN(6);
    const float* const in15 = PIN(15);
    const float* const in10 = PIN(10);
    const float* const in8 = PIN(8);
    const float* const in9 = PIN(9);
    const float* const in11 = PIN(11);
    const float* const in12 = PIN(12);
    const float* const in2 = PIN(2);
    const float* const in3 = PIN(3);
    const float* const in13 = PIN(13);
    const float* const in14 = PIN(14);
    float* const outp = POUT();
    const float* gain = in6 + layer * 1024; const float* dsk = in15 + layer * 1024;
    const int g = gw & 63, p = lane;
    const int idx = (layer * 64 + g) * 64 + p;
    const float dt = expf(in10[idx]), are = in8[idx], aim = in9[idx];
    const float mag = expf(are * dt); float sn, cs; sincos_ang(aim * dt, sn, cs);
    const float lbr = mag * cs, lbi = mag * sn;
    const float den = 1.0f / (are * are + aim * aim);
    const float cr = ((lbr - 1.f) * are + lbi * aim) * den, ci = (lbi * are - (lbr - 1.f) * aim) * den;
    float bbr[16], bbi[16], ccr[16], cci[16], gg[16];
#pragma unroll
    for (int c4 = 0; c4 < 4; ++c4) { const f32x4 br = *(const f32x4*)(in11 + (size_t)idx * 16 + 4 * c4), bi = *(const f32x4*)(in12 + (size_t)idx * 16 + 4 * c4);
#pragma unroll
        for (int e = 0; e < 4; ++e) { bbr[4 * c4 + e] = cr * br[e] - ci * bi[e]; bbi[4 * c4 + e] = cr * bi[e] + ci * br[e]; } }
#pragma unroll
    for (int c = 0; c < 16; ++c) { const size_t co = ((size_t)(layer * 64 + g) * 16 + c) * 64 + p; ccr[c] = in13[co]; cci[c] = in14[co]; gg[c] = gain[16 * g + c]; }
    const float gl = gain[16 * g + (lane & 15)], dl = dsk[16 * g + (lane & 15)];
    for (int it0 = gw; it0 < NS * 64; it0 += 4 * NGW) {
        f32x4 xv[4][4]; float ux[4][16], s0r[4], s0i[4], ul[4];
#pragma unroll
        for (int k = 0; k < 4; ++k) { const int it = it0 + k * NGW; const int b = (it < NS * 64) ? (it >> 6) : 0;
#pragma unroll
            for (int jx = 0; jx < 4; ++jx) xv[k][jx] = *(const f32x4*)(xs + (size_t)b * 1024 + 4 * lane + 256 * jx);
#pragma unroll
            for (int c = 0; c < 16; ++c) ux[k][c] = xs[(size_t)b * 1024 + 16 * g + c];
            ul[k] = xs[(size_t)b * 1024 + 16 * g + (lane & 15)];
            const size_t sidx = ((size_t)(layer * 128 + b) * 64 + g) * 64 + p; s0r[k] = in2[sidx]; s0i[k] = in3[sidx]; }
#pragma unroll
        for (int k = 0; k < 4; ++k) { const int it = it0 + k * NGW; if (it < NS * 64) {
            const int b = it >> 6;
            float ssq = 0.f;
#pragma unroll
            for (int jx = 0; jx < 4; ++jx) { const f32x4 v = xv[k][jx]; ssq += (v[0] * v[0] + v[1] * v[1]) + (v[2] * v[2] + v[3] * v[3]); }
            const float rs = rsqrtf(wave_sum(ssq) * (1.0f / 1024.0f) + EPS);
            float bur = 0.f, bui = 0.f;
#pragma unroll
            for (int c = 0; c < 16; ++c) { const float u = ux[k][c] * rs * gg[c]; bur += bbr[c] * u; bui += bbi[c] * u; }
            const size_t sidx = ((size_t)(layer * 128 + b) * 64 + g) * 64 + p;
            const float nr = lbr * s0r[k] - lbi * s0i[k] + bur, ni = lbr * s0i[k] + lbi * s0r[k] + bui;
            outp[O_SSRE + sidx] = nr; outp[O_SSIM + sidx] = ni;
            float myy = 0.f;
#pragma unroll
            for (int c = 0; c < 16; ++c) { const float y = wave_sum(ccr[c] * nr - cci[c] * ni); if (lane == c) myy = y; }
            if (lane < 16) gs[(size_t)b * 1024 + 16 * g + lane] = gelu_tanh(myy + dl * (ul[k] * rs * gl));
        } }
    }
}

template <int NT, int CH>
DEVI void sgq_core(const float* A, int lda, int row0, int k0, int nks, const bf16_t* const (&bp)[NT], f32x4 (&acc)[NT], float& ssq, int lane) {
    const float* ap = A + (size_t)(row0 + (lane & 15)) * lda + k0 + 8 * (lane >> 4);
    ssq = 0.f;
#pragma unroll
    for (int nt = 0; nt < NT; ++nt) acc[nt] = (f32x4){0.f, 0.f, 0.f, 0.f};
#pragma unroll 1
    for (int kb = 0; kb < nks; kb += CH) {
        f32x4 a0[CH], a1[CH]; bf16x8 b[CH][NT];
#pragma unroll
        for (int i = 0; i < CH; ++i) { a0[i] = *(const f32x4*)(ap + 32 * (kb + i)); a1[i] = *(const f32x4*)(ap + 32 * (kb + i) + 4);
#pragma unroll
            for (int nt = 0; nt < NT; ++nt) b[i][nt] = *(const bf16x8*)(bp[nt] + 32 * (kb + i)); }
#pragma unroll
        for (int i = 0; i < CH; ++i) {
            ssq += (a0[i][0] * a0[i][0] + a0[i][1] * a0[i][1]) + (a0[i][2] * a0[i][2] + a0[i][3] * a0[i][3]) + (a1[i][0] * a1[i][0] + a1[i][1] * a1[i][1]) + (a1[i][2] * a1[i][2] + a1[i][3] * a1[i][3]);
            u32x4 au; au.x = pkbf(a0[i][0], a0[i][1]); au.y = pkbf(a0[i][2], a0[i][3]); au.z = pkbf(a1[i][0], a1[i][1]); au.w = pkbf(a1[i][2], a1[i][3]);
            const bf16x8 af = __builtin_bit_cast(bf16x8, au);
#pragma unroll
            for (int nt = 0; nt < NT; ++nt) acc[nt] = MFMA16(af, b[i][nt], acc[nt]);
        }
    }
    ssq += __shfl_xor(ssq, 16); ssq += __shfl_xor(ssq, 32);
}
template <int CH>
DEVI void sgq_core_b16(const bf16_t* A, int lda, int row0, int k0, int nks, const bf16_t* bp, f32x4& acc, int lane) {
    const bf16_t* ap = A + (size_t)(row0 + (lane & 15)) * lda + k0 + 8 * (lane >> 4);
    acc = (f32x4){0.f, 0.f, 0.f, 0.f};
#pragma unroll 1
    for (int kb = 0; kb < nks; kb += CH) {
        bf16x8 a[CH], b[CH];
#pragma unroll
        for (int i = 0; i < CH; ++i) { a[i] = *(const bf16x8*)(ap + 32 * (kb + i)); b[i] = *(const bf16x8*)(bp + 32 * (kb + i)); }
#pragma unroll
        for (int i = 0; i < CH; ++i) acc = MFMA16(a[i], b[i], acc);
    }
}
template <int NT> DEVI bool sgq_reduce(LAS unsigned char* lds, f32x4 (&acc)[NT], float& ssq, int wave, int lane) {
    LAS f32x4* red = (LAS f32x4*)lds;
    LAS float* rss = (LAS float*)(lds + 32768);
    __syncthreads();
#pragma unroll
    for (int nt = 0; nt < NT; ++nt) red[(wave * NT + nt) * 64 + lane] = acc[nt];
    rss[wave * 64 + lane] = ssq;
    __syncthreads();
    const int rt = wave & 1;
    if ((wave >> 1) != 0) return false;
#pragma unroll
    for (int nt = 0; nt < NT; ++nt) acc[nt] = (red[(rt * NT + nt) * 64 + lane] + red[((2 + rt) * NT + nt) * 64 + lane]) + (red[((4 + rt) * NT + nt) * 64 + lane] + red[((6 + rt) * NT + nt) * 64 + lane]);
    ssq = (rss[rt * 64 + lane] + rss[(2 + rt) * 64 + lane]) + (rss[(4 + rt) * 64 + lane] + rss[(6 + rt) * 64 + lane]);
    return true;
}
DEVI void row_rstd(float ssq, float (&rs)[4], int lane) {
    const float r = rsqrtf(ssq * (1.0f / 1024.0f) + EPS);
#pragma unroll
    for (int q = 0; q < 4; ++q) rs[q] = __shfl(r, 4 * (lane >> 4) + q);
}
DEVI void sample_glu(int layer, LAS unsigned char* lds, const float* gs, float* xs, int vcu, int G, int wave, int lane) {
    const float* const in17 = PIN(17);
    unsigned char* const wsp = PWS();
    const bf16_t* Wt = (const bf16_t*)(wsp + WS_WGLU) + (size_t)layer * 2048 * 1024; const float* bias = in17 + layer * 2048;
    for (int it = vcu; it < 256; it += G) {
        const int s = it >> 2, rq = it & 3, n = lane & 15, rt = wave & 1, kq = wave >> 1, row0 = 32 * rq + 16 * rt, rv = 256 * (s >> 3) + 16 * (s & 7) + n;
        const bf16_t* bp[2] = {Wt + (size_t)rv * 1024 + 256 * kq + 8 * (lane >> 4), Wt + (size_t)(rv + 128) * 1024 + 256 * kq + 8 * (lane >> 4)};
        f32x4 acc[2]; float ssq; sgq_core<2, 8>(gs, 1024, row0, 256 * kq, 8, bp, acc, ssq, lane);
        if (sgq_reduce<2>(lds, acc, ssq, wave, lane)) {
            const int col = 16 * s + n; const float bv = bias[col], bg = bias[1024 + col];
#pragma unroll
            for (int q = 0; q < 4; ++q) { const int row = row0 + 4 * (lane >> 4) + q; xs[(size_t)row * 1024 + col] += (acc[0][q] + bv) * sigmoidf_(acc[1][q] + bg); }
        }
    }
}
DEVI void sample_mlpin(int layer, LAS unsigned char* lds, const float* xs, bf16_t* hs, int vcu, int G, int wave, int lane) {
    unsigned char* const wsp = PWS();
    const bf16_t* Wt = (const bf16_t*)(wsp + WS_WIN) + (size_t)layer * 4096 * 1024;
    for (int it = vcu; it < 256; it += G) {
        const int cgp = it >> 2, rq = it & 3, n = lane & 15, rt = wave & 1, kq = wave >> 1, row0 = 32 * rq + 16 * rt;
        const bf16_t* bp[4];
#pragma unroll
        for (int nt = 0; nt < 4; ++nt) bp[nt] = Wt + (size_t)(64 * cgp + 16 * nt + n) * 1024 + 256 * kq + 8 * (lane >> 4);
        f32x4 acc[4]; float ssq; sgq_core<4, 8>(xs, 1024, row0, 256 * kq, 8, bp, acc, ssq, lane);
        if (sgq_reduce<4>(lds, acc, ssq, wave, lane)) {
            float rs[4]; row_rstd(ssq, rs, lane);
#pragma unroll
            for (int q = 0; q < 4; ++q) { const int row = row0 + 4 * (lane >> 4) + q;
#pragma unroll
                for (int nt = 0; nt < 4; ++nt) { const float v = fmaxf(acc[nt][q] * rs[q], 0.f); hs[(size_t)row * 4096 + 64 * cgp + 16 * nt + n] = (bf16_t)(pkbf(v * v, 0.f) & 0xffffu); } }
        }
    }
}
DEVI void sample_mlpout(int layer, LAS unsigned char* lds, const bf16_t* hs, float* xs, int vcu, int G, int wave, int lane) {
    unsigned char* const wsp = PWS();
    const bf16_t* Wt = (const bf16_t*)(wsp + WS_WOUT) + (size_t)layer * 1024 * 4096;
    for (int it = vcu; it < 256; it += G) {
        const int s = it >> 2, rq = it & 3, n = lane & 15, rt = wave & 1, kq = wave >> 1, row0 = 32 * rq + 16 * rt;
        const bf16_t* bp[1] = {Wt + (size_t)(16 * s + n) * 4096 + 1024 * kq + 8 * (lane >> 4)};
        f32x4 acc[1]; float ssq = 0.f; sgq_core_b16<32>(hs, 4096, row0, 1024 * kq, 32, bp[0], acc[0], lane);
        if (sgq_reduce<1>(lds, acc, ssq, wave, lane)) {
#pragma unroll
            for (int q = 0; q < 4; ++q) { const int row = row0 + 4 * (lane >> 4) + q; xs[(size_t)row * 1024 + 16 * s + n] += acc[0][q]; }
        }
    }
}
DEVI void sample_oproj(int j, LAS unsigned char* lds, const float* os, float* xs, int vcu, int G, int wave, int lane) {
    unsigned char* const wsp = PWS();
    const bf16_t* Wt = (const bf16_t*)(wsp + WS_WO) + (size_t)j * 1024 * 1024;
    for (int it = vcu; it < 256; it += G) {
        const int s = it >> 2, rq = it & 3, n = lane & 15, rt = wave & 1, kq = wave >> 1, row0 = 32 * rq + 16 * rt;
        const bf16_t* bp[1] = {Wt + (size_t)(16 * s + n) * 1024 + 256 * kq + 8 * (lane >> 4)};
        f32x4 acc[1]; float ssq; sgq_core<1, 8>(os, 1024, row0, 256 * kq, 8, bp, acc, ssq, lane);
        if (sgq_reduce<1>(lds, acc, ssq, wave, lane)) {
#pragma unroll
            for (int q = 0; q < 4; ++q) { const int row = row0 + 4 * (lane >> 4) + q; xs[(size_t)row * 1024 + 16 * s + n] += acc[0][q]; }
        }
    }
}
DEVI void sample_qkv(int j, LAS unsigned char* lds, const float* xs, float* qs, int vcu, int G, int wave, int lane) {
    const float* const in23 = PIN(23);
    const float* const in21 = PIN(21);
    float* const outp = POUT();
    unsigned char* const wsp = PWS();
    const bf16_t* Wt = (const bf16_t*)(wsp + (j == 0 ? WS_WQKV : WS_WQ1));
    const float* rope = (const float*)(wsp + WS_ROPE) + (size_t)4096 * 64;
    const int nitems = (j == 0) ? 96 : 64;
    const bool idle_half = (j == 0) && (G == 256);
    if (idle_half && (vcu & 31) < 16) return;
    const int first = idle_half ? ((vcu >> 5) * 16 + (vcu & 31) - 16) : vcu, stride = idle_half ? 128 : G;
    for (int it0 = first; it0 < nitems; it0 += stride) {
        const int it = it0 >> 2, rq = it0 & 3, rt = wave & 1, kq = wave >> 1, row0 = 32 * rq + 16 * rt;
        const int n = lane & 15; int rows[4]; int kind, hd;
        if (it < 16) { kind = 0; hd = it;
#pragma unroll
            for (int nt = 0; nt < 4; ++nt) rows[nt] = 256 * (hd >> 2) + 128 * (nt >> 1) + 32 * (hd & 3) + 16 * (nt & 1) + n; }
        else if (it < 20) { kind = 1; hd = it - 16;
#pragma unroll
            for (int nt = 0; nt < 4; ++nt) rows[nt] = 1024 + 128 * (nt >> 1) + 32 * hd + 16 * (nt & 1) + n; }
        else { kind = 2; hd = it - 20;
#pragma unroll
            for (int nt = 0; nt < 4; ++nt) rows[nt] = 1280 + 64 * hd + 16 * nt + n; }
        const bf16_t* bp[4];
#pragma unroll
        for (int nt = 0; nt < 4; ++nt) bp[nt] = Wt + (size_t)rows[nt] * 1024 + 256 * kq + 8 * (lane >> 4);
        f32x4 acc[4]; float ssq; sgq_core<4, 8>(xs, 1024, row0, 256 * kq, 8, bp, acc, ssq, lane);
        if (sgq_reduce<4>(lds, acc, ssq, wave, lane)) {
            float rs[4]; row_rstd(ssq, rs, lane);
#pragma unroll
            for (int q = 0; q < 4; ++q) {
                const int row = row0 + 4 * (lane >> 4) + q;
                float v[4];
#pragma unroll
                for (int nt = 0; nt < 4; ++nt) v[nt] = acc[nt][q] * rs[q];
                if (kind == 2) {
#pragma unroll
                    for (int nt = 0; nt < 4; ++nt) outp[O_VS + ((size_t)(row * 128 + 127) * 4 + hd) * 64 + 16 * nt + n] = v[nt];
                } else {
                    float sq = (v[0] * v[0] + v[1] * v[1]) + (v[2] * v[2] + v[3] * v[3]);
                    sq += __shfl_xor(sq, 1); sq += __shfl_xor(sq, 2); sq += __shfl_xor(sq, 4); sq += __shfl_xor(sq, 8);
                    const float rn = rsqrtf(sq * (1.0f / 64.0f) + EPS);
                    const float* gn = (kind == 0) ? (in23 + j * 64) : in21;
                    float o[4];
#pragma unroll
                    for (int t = 0; t < 2; ++t) { const int d = 16 * t + n; const float cs = rope[d], sn = rope[32 + d];
                        const float x1 = v[t] * rn * gn[d], x2 = v[t + 2] * rn * gn[32 + d];
                        o[t] = x1 * cs - x2 * sn; o[t + 2] = x2 * cs + x1 * sn; }
                    float* dst = (kind == 0) ? (qs + (size_t)row * 1024 + hd * 64) : (outp + O_KS + ((size_t)(row * 128 + 127) * 4 + hd) * 64);
#pragma unroll
                    for (int nt = 0; nt < 4; ++nt) dst[16 * nt + n] = o[nt];
                }
            }
        }
    }
}
DEVI void sample_attn(int j, LAS unsigned char* lds, const float* qs, float* os, int vcu, int G, int wave, int lane) {
    const float* const in24 = PIN(24);
    const float* const in4 = PIN(4);
    const float* const in5 = PIN(5);
    float* const outp = POUT();
    LAS float* L = (LAS float*)lds;
    for (int wi = vcu; wi < 256; wi += G) {
        const int itm = wave >> 2, q = wave & 3, it = 2 * wi + itm, b = it >> 2, kvh = it & 3;
        const float* sinks = in24 + j * 16 + kvh * 4;
        __syncthreads();
        L[itm * 256 + q * 64 + lane] = qs[(size_t)b * 1024 + (kvh * 4 + q) * 64 + lane];
        const int rr = lane & 31, hf = lane >> 5, row = 32 * q + rr;
        const float* kp = in4 + ((size_t)(b * 128 + row) * 4 + kvh) * 64 + 32 * hf;
        f32x4 kv[8];
#pragma unroll
        for (int i = 0; i < 8; ++i) kv[i] = *(const f32x4*)(kp + 4 * i);
        float vv[32]; const float* vp = in5 + ((size_t)(b * 128 + 32 * q) * 4 + kvh) * 64 + lane;
#pragma unroll
        for (int i = 0; i < 32; ++i) vv[i] = vp[(size_t)i * 256];
        const float kn = outp[O_KS + ((size_t)(b * 128 + 127) * 4 + kvh) * 64 + lane], vn = outp[O_VS + ((size_t)(b * 128 + 127) * 4 + kvh) * 64 + lane];
        __syncthreads();
        float a[4], an[4];
#pragma unroll
        for (int hh = 0; hh < 4; ++hh) {
            float sd = 0.f;
#pragma unroll
            for (int i = 0; i < 8; ++i) { const f32x4 qq = *(const LAS f32x4*)(L + itm * 256 + hh * 64 + 32 * hf + 4 * i); sd += (kv[i][0] * qq[0] + kv[i][1] * qq[1]) + (kv[i][2] * qq[2] + kv[i][3] * qq[3]); }
            sd += __shfl_xor(sd, 32);
            a[hh] = (row >= 1) ? sd * 0.125f : -INFINITY;
            an[hh] = wave_sum(kn * L[itm * 256 + hh * 64 + lane]) * 0.125f;
            const float mw = wave_max(a[hh]);
            if (lane == 0) L[512 + ((itm * 4 + q) * 4 + hh) * 2] = mw;
        }
        __syncthreads();
        float m[4];
#pragma unroll
        for (int hh = 0; hh < 4; ++hh) {
            float mm = fmaxf(an[hh], sinks[hh]);
#pragma unroll
            for (int w = 0; w < 4; ++w) mm = fmaxf(mm, L[512 + ((itm * 4 + w) * 4 + hh) * 2]);
            m[hh] = mm;
            const float p = __expf(a[hh] - mm);
            const float sw = wave_sum(p) * 0.5f;
            if (lane == 0) L[512 + ((itm * 4 + q) * 4 + hh) * 2 + 1] = sw;
            if (lane < 32) L[640 + (itm * 4 + hh) * 132 + row] = p;
        }
        __syncthreads();
#pragma unroll
        for (int hh = 0; hh < 4; ++hh) {
            float o = 0.f;
#pragma unroll
            for (int i = 0; i < 32; ++i) o += L[640 + (itm * 4 + hh) * 132 + 32 * q + i] * vv[i];
            if (q == 3) o += __expf(an[hh] - m[hh]) * vn;
            L[1792 + ((itm * 4 + q) * 4 + hh) * 64 + lane] = o;
        }
        __syncthreads();
#pragma unroll
        for (int hh = 0; hh < 4; ++hh) if (hh == q) {
            float tot = __expf(an[hh] - m[hh]) + __expf(sinks[hh] - m[hh]);
            tot += (L[512 + ((itm * 4 + 0) * 4 + hh) * 2 + 1] + L[512 + ((itm * 4 + 1) * 4 + hh) * 2 + 1]) + (L[512 + ((itm * 4 + 2) * 4 + hh) * 2 + 1] + L[512 + ((itm * 4 + 3) * 4 + hh) * 2 + 1]);
            const float val = (L[1792 + ((itm * 4 + 0) * 4 + hh) * 64 + lane] + L[1792 + ((itm * 4 + 1) * 4 + hh) * 64 + lane]) + (L[1792 + ((itm * 4 + 2) * 4 + hh) * 64 + lane] + L[1792 + ((itm * 4 + 3) * 4 + hh) * 64 + lane]);
            os[(size_t)b * 1024 + (kvh * 4 + hh) * 64 + lane] = val / tot;
        }
    }
    __syncthreads();
}

DEVI void attn_prompt(LAS unsigned char* lds, const bf16_t* Q, const bf16_t* Kb, const bf16_t* Vb, bf16_t* O, const float* sinks, int vcu, int G, int tid, int wave, int lane) {
    constexpr int KP = 144, VP = 528, VOFF = 256 * KP;
    const int ql = lane & 31, h = lane >> 5;
    for (int it = vcu; it < 512; it += G) {
        const int kvh = it & 3, qb = (it >> 2) & 31, b = it >> 7;
        __syncthreads();
        const int hq = kvh * 4 + (wave >> 1);
        bf16x8 qfa[2][4];
#pragma unroll
        for (int j = 0; j < 2; ++j)
#pragma unroll
            for (int s = 0; s < 4; ++s) qfa[j][s] = *(const bf16x8*)(Q + ((size_t)b * 4096 + qb * 128 + 32 * (2 * (wave & 1) + j) + ql) * 1024 + hq * 64 + 16 * s + 8 * h);
        const long tok0 = (long)b * 4096 + (long)(qb - 1) * 128;
#pragma unroll
        for (int i = 0; i < 4; ++i) {
            const int kk = (tid >> 3) + 64 * i, ch = tid & 7; const bool ok = (qb > 0) || (kk >= 128);
            u32x4 kv = {0u, 0u, 0u, 0u}, vv = {0u, 0u, 0u, 0u};
            if (ok) { kv = *(const u32x4*)(Kb + (size_t)(tok0 + kk) * 256 + kvh * 64 + 8 * ch); vv = *(const u32x4*)(Vb + (size_t)(tok0 + kk) * 256 + kvh * 64 + 8 * ch); }
            *(LAS u32x4*)(lds + kk * KP + 16 * ch) = kv;
            const int o = kk & 15, pos = (kk & ~15) + 8 * ((o >> 2) & 1) + 4 * (o >> 3) + (o & 3);
#pragma unroll
            for (int jx = 0; jx < 8; ++jx) *(LAS unsigned short*)(lds + VOFF + (8 * ch + jx) * VP + 2 * pos) = (unsigned short)(vv[jx >> 1] >> (16 * (jx & 1)));
        }
        __syncthreads();
        const float sink2 = sinks[hq] * LOG2E;
#pragma unroll
        for (int j = 0; j < 2; ++j) {
            const int jj = 2 * (wave & 1) + j;
            const size_t qtok = (size_t)b * 4096 + qb * 128 + 32 * jj + ql;
            const bf16x8 (&qf)[4] = qfa[j];
            f32x16 sc[5];
#pragma unroll
            for (int tt = 0; tt < 5; ++tt) {
                f32x16 acc = {};
#pragma unroll
                for (int s = 0; s < 4; ++s) { const bf16x8 ka = *(const LAS bf16x8*)(lds + (32 * (jj + tt) + ql) * KP + (16 * s + 8 * h) * 2); acc = MFMA32(ka, qf[s], acc); }
                sc[tt] = acc;
            }
            float mx = sink2;
#pragma unroll
            for (int tt = 0; tt < 5; ++tt)
#pragma unroll
                for (int i = 0; i < 16; ++i) {
                    const int krow = (i & 3) + 8 * (i >> 2) + 4 * h, kk = 32 * (jj + tt) + krow;
                    bool valid = (tt == 0) ? (krow > ql) : ((tt == 4) ? (krow <= ql) : true);
                    if (qb == 0 && kk < 128) valid = false;
                    const float v = valid ? sc[tt][i] : -INFINITY; sc[tt][i] = v; mx = fmaxf(mx, v);
                }
            mx = fmaxf(mx, __shfl_xor(mx, 32));
            float sum = 0.f;
#pragma unroll
            for (int tt = 0; tt < 5; ++tt)
#pragma unroll
                for (int i = 0; i < 16; ++i) { const float p = __builtin_amdgcn_exp2f(sc[tt][i] - mx); sc[tt][i] = p; sum += p; }
            sum += __shfl_xor(sum, 32);
            const float inv = 1.0f / (sum + __builtin_amdgcn_exp2f(sink2 - mx));
            f32x16 o[2] = {{}, {}};
#pragma unroll
            for (int tt = 0; tt < 5; ++tt)
#pragma unroll
                for (int s2 = 0; s2 < 2; ++s2) {
                    u32x4 pu; pu.x = pkbf(sc[tt][8 * s2 + 0], sc[tt][8 * s2 + 1]); pu.y = pkbf(sc[tt][8 * s2 + 2], sc[tt][8 * s2 + 3]);
                    pu.z = pkbf(sc[tt][8 * s2 + 4], sc[tt][8 * s2 + 5]); pu.w = pkbf(sc[tt][8 * s2 + 6], sc[tt][8 * s2 + 7]);
                    const bf16x8 pb = __builtin_bit_cast(bf16x8, pu);
#pragma unroll
                    for (int dt = 0; dt < 2; ++dt) { const bf16x8 va = *(const LAS bf16x8*)(lds + VOFF + (32 * dt + ql) * VP + (32 * (jj + tt) + 16 * s2 + 8 * h) * 2); o[dt] = MFMA32(va, pb, o[dt]); }
                }
#pragma unroll
            for (int dt = 0; dt < 2; ++dt)
#pragma unroll
                for (int i4 = 0; i4 < 4; ++i4) {
                    u32x2 w; w.x = pkbf(o[dt][4 * i4] * inv, o[dt][4 * i4 + 1] * inv); w.y = pkbf(o[dt][4 * i4 + 2] * inv, o[dt][4 * i4 + 3] * inv);
                    *(u32x2*)(O + qtok * 1024 + hq * 64 + 32 * dt + 8 * i4 + 4 * h) = w;
                }
        }
    }
    __syncthreads();
}

#define XB_TMO      128
#define XB_XCNT(j)  (256  + 64 * (j))
#define XB_XSUB(j)  (1280 + 64 * (j))
#define XB_XGEN(j)  (2304 + 64 * (j))
#define XB_TOP      3328
#define XB_TOPGEN   3392
#define XCD_BAR_WORDS 3456
#define XB_SPIN_CAP (1u << 18)

__device__ __forceinline__ unsigned xb_ld(unsigned* p)              { return __hip_atomic_load(p, __ATOMIC_RELAXED, __HIP_MEMORY_SCOPE_AGENT); }
__device__ __forceinline__ unsigned xb_add(unsigned* p, unsigned v) { return __hip_atomic_fetch_add(p, v, __ATOMIC_RELAXED, __HIP_MEMORY_SCOPE_AGENT); }
__device__ __forceinline__ unsigned xb_xcc_id() { return (unsigned)__builtin_amdgcn_s_getreg((3 << 11) | 20) & 0xFu; }
#define XB_SPIN(cond, bar) do { unsigned _sp = 0; while (cond) { __builtin_amdgcn_s_sleep(1); \
    if ((++_sp & 255u) == 0u) { if (xb_ld(&(bar)[XB_TMO])) break; if (_sp > XB_SPIN_CAP) { atomicAdd(&(bar)[XB_TMO], 1u); break; } } } } while (0)

struct XcdBarrier {
    unsigned* bar; unsigned x;
    volatile LAS unsigned* st;
};

__device__ __forceinline__ XcdBarrier xcd_barrier_post(unsigned* bar, volatile LAS unsigned* st) {
    XcdBarrier b; b.bar = bar; b.x = xb_xcc_id(); b.st = st;
    if (threadIdx.x == 0) (void)xb_add(&bar[XB_XCNT(b.x)], 1u);
    return b;
}
__device__ __forceinline__ void xcd_barrier_complete(unsigned* bar, unsigned x, unsigned& nloc, unsigned& nx) {
    const unsigned G = gridDim.x * gridDim.y * gridDim.z;
    unsigned sum, cnt, mine, sp = 0u;
    for (;;) {
        sum = 0u; cnt = 0u; mine = 0u;
#pragma unroll
        for (unsigned j = 0; j < 16; ++j) { const unsigned c = xb_ld(&bar[XB_XCNT(j)]); sum += c; cnt += (c > 0u) ? 1u : 0u; mine = (j == x) ? c : mine; }
        if (sum == G) break;
        __builtin_amdgcn_s_sleep(1);
        if ((++sp & 255u) == 0u) { if (xb_ld(&bar[XB_TMO])) break; if (sp > XB_SPIN_CAP) { atomicAdd(&bar[XB_TMO], 1u); break; } }
    }
    nloc = mine > 0u ? mine : 1u; nx = cnt > 0u ? cnt : 1u;
}

__device__ __forceinline__ void xcd_barrier(const XcdBarrier& b, unsigned kbar) {
    asm volatile("s_waitcnt vmcnt(0)" ::: "memory");
    __syncthreads();
    if (threadIdx.x == 0) {
        unsigned* bar = b.bar;
        __builtin_amdgcn_s_waitcnt(0);
        asm volatile("buffer_inv sc1" ::: "memory");
        unsigned nloc = b.st[0], nx = b.st[1];
        if (nloc == 0u) { xcd_barrier_complete(bar, b.x, nloc, nx); b.st[0] = nloc; b.st[1] = nx; }
        const unsigned old = xb_add(&bar[XB_XSUB(b.x)], 1u);
        const unsigned gen = old / nloc;
        if (old + 1u == (gen + 1u) * nloc) {
            __builtin_amdgcn_fence(__ATOMIC_RELEASE, "agent");
            asm volatile("s_waitcnt vmcnt(0)" ::: "memory");
            const unsigned og = xb_add(&bar[XB_TOP], 1u);
            const unsigned tg = og / nx;
            if (og + 1u == (tg + 1u) * nx) xb_add(&bar[XB_TOPGEN], 1u);
            else XB_SPIN(xb_ld(&bar[XB_TOPGEN]) == tg, bar);
            asm volatile("" ::: "memory");
            asm volatile("s_waitcnt vmcnt(0)" ::: "memory");
        } else {
            XB_SPIN(xb_ld(&bar[XB_TOPGEN]) <= kbar, bar);
            asm volatile("" ::: "memory");
            asm volatile("s_waitcnt vmcnt(0)" ::: "memory");
        }
    }
    __syncthreads();
}

constexpr int NPHASE = 21;
#ifndef NPH_RUN
#define NPH_RUN NPHASE
#endif
#ifndef KMASK
#define KMASK 0xffff
#endif
#define KON(b) ((KMASK >> (b)) & 1)
#ifndef REPMASK
#define REPMASK 0
#endif
#ifndef BARX2
#define BARX2 0
#endif
#define NREP(b) ((((REPMASK) >> (b)) & 1) ? 2 : 1)
DEVI int opaque_tid() { int t; asm volatile("v_mov_b32 %0, %1" : "=v"(t) : "v"((int)threadIdx.x)); return t; }
DEVI int opaque_bid() { int b; asm volatile("s_mov_b32 %0, %1" : "=s"(b) : "s"((int)blockIdx.x)); return b; }
#define GEO() const int tid = opaque_tid(), lane = tid & 63, wave = __builtin_amdgcn_readfirstlane(tid >> 6); \
    const int G = gridDim.x, bx = opaque_bid(), vcu = (G % 8 == 0) ? (bx % 8) * (G / 8) + bx / 8 : bx; \
    const int gw = vcu * NWAVES + wave, NGW = G * NWAVES; (void)gw; (void)NGW; (void)lane; (void)tid; (void)vcu
__global__ void __launch_bounds__(NWAVES * 64, 2) yoco_fwd(Args args) {
    extern __shared__ __attribute__((aligned(16))) unsigned char lds_raw[];
    LAS unsigned char* lds = (LAS unsigned char*)lds_raw;
    if (threadIdx.x == 0) {
        LAS unsigned long long* PT = (LAS unsigned long long*)(lds + PT_OFF);
#pragma unroll
        for (int k = 0; k < 28; ++k) PT[k] = (unsigned long long)args.in[k];
        PT[28] = (unsigned long long)args.out; PT[29] = (unsigned long long)args.ws;
        ((LAS unsigned*)(lds + PT_OFF + 512))[0] = 0u; ((LAS unsigned*)(lds + PT_OFF + 512))[1] = 0u;
    }
    __syncthreads();
    const int lo = args.ph_lo, hi = args.ph_hi;
#if MULTI
#define SEAM(k) do {} while (0)
#else
    cg::grid_group grid = cg::this_grid();
    (void)xcd_barrier_post((unsigned*)args.ws, (volatile LAS unsigned*)(lds + PT_OFF + 512));
#define SEAM(k) do { if (lo <= (k) && (k) + 1 < hi) { if (hi < 0) grid.sync(); else { XcdBarrier xb_; xb_.bar = (unsigned*)PWS(); xb_.x = xb_xcc_id(); xb_.st = (volatile LAS unsigned*)(lds + PT_OFF + 512); xcd_barrier(xb_, (unsigned)(k)); } } } while (0)
#endif
#define IN(k) (lo <= (k) && (k) < hi)

    if (KON(0) && IN(0)) for (int rp_ = 0; rp_ < NREP(0); ++rp_) { GEO(); prologue(args, lds, vcu, G, tid, wave, lane); }
    SEAM(0);
#pragma unroll 1
    for (int L = 0; L < 2; ++L) {
        const int pb = 1 + 5 * L;
        if (KON(1) && IN(pb)) for (int rp_ = 0; rp_ < NREP(1); ++rp_) { GEO(); unsigned char* ws = PWS(); const bf16_t* xin = (const bf16_t*)(ws + WS_XB);
            s5_pass<false>(lds, L, xin, (const float*)(ws + WS_PS), PIN(6) + L * 1024, PIN(15) + L * 1024, ws, ws, nullptr, nullptr, vcu, G, tid, wave, lane); }
        SEAM(pb);
        if (IN(pb + 1)) {
            if (KON(2)) for (int rp_ = 0; rp_ < NREP(2); ++rp_) { GEO(); unsigned char* ws = PWS(); float* out = POUT(); const bf16_t* xin = (const bf16_t*)(ws + WS_XB);
                s5_pass<true>(lds, L, xin, (const float*)(ws + WS_PS), PIN(6) + L * 1024, PIN(15) + L * 1024, ws, ws, out + O_SPRE, out + O_SPIM, vcu, G, tid, wave, lane); }
            if (KON(9)) for (int rp_ = 0; rp_ < NREP(10); ++rp_) { GEO(); unsigned char* ws = PWS(); float* out = POUT(); s5_sample(L, out + O_YS, (float*)(ws + WS_GS), gw, NGW, lane); }
        }
        SEAM(pb + 1);
        if (IN(pb + 2)) {
            if (KON(3)) { const int G = gridDim.x, bx = opaque_bid(); unsigned char* ws = PWS(); float* PS = (float*)(ws + WS_PS);
                pg8::Gemm g{(const bf16_t*)(ws + WS_G), (const bf16_t*)(ws + WS_WGLU) + (size_t)L * 2048 * 1024, MP, 2048, 1024}; pg8::StaticOrder S; S.init(MP, 2048, G, bx);
                pg8::EpiGlu E{(bf16_t*)(ws + WS_XB), PS, PIN(17) + L * 2048};
                pg8::gemm_phase<pg8::EpiGlu, pg8::StaticOrder, true, true>(lds, g, S, E); }
            if (KON(9)) { GEO(); unsigned char* ws = PWS(); float* out = POUT(); sample_glu(L, lds, (const float*)(ws + WS_GS), out + O_YS, vcu, G, wave, lane); }
        }
        SEAM(pb + 2);
        if (IN(pb + 3)) {
            if (KON(4)) for (int rp_ = 0; rp_ < NREP(4); ++rp_) { const int G = gridDim.x, bx = opaque_bid(); unsigned char* ws = PWS(); float* PS = (float*)(ws + WS_PS);
                pg8::Gemm g{(const bf16_t*)(ws + WS_XB), (const bf16_t*)(ws + WS_WIN) + (size_t)L * 4096 * 1024, MP, 4096, 1024}; pg8::StaticOrder S; S.init(MP, 4096, G, bx);
                pg8::EpiMlpIn<8> E{(bf16_t*)(ws + WS_H), PS, __builtin_amdgcn_make_buffer_rsrc((void*)ws, (short)0, (int)WS_END, 0x00020000)};
                pg8::gemm_phase<pg8::EpiMlpIn<8>, pg8::StaticOrder, true, true>(lds, g, S, E); }
            if (KON(9)) for (int rp_ = 0; rp_ < NREP(10); ++rp_) { GEO(); unsigned char* ws = PWS(); float* out = POUT(); sample_mlpin(L, lds, out + O_YS, (bf16_t*)(ws + WS_HS), vcu, G, wave, lane); }
        }
        SEAM(pb + 3);
        if (IN(pb + 4)) {
            if (KON(5)) { const int G = gridDim.x, bx = opaque_bid(); unsigned char* ws = PWS(); float* out = POUT(); float* PS = (float*)(ws + WS_PS);
                pg8::Gemm g{(const bf16_t*)(ws + WS_H), (const bf16_t*)(ws + WS_WOUT) + (size_t)L * 1024 * 4096, MP, 1024, 4096}; pg8::StaticOrder S; S.init(MP, 1024, G, bx);
                pg8::EpiResid E{(bf16_t*)(ws + WS_XB), nullptr, PS};
                pg8::gemm_phase<pg8::EpiResid, pg8::StaticOrder, false, true>(lds, g, S, E); }
            if (KON(9)) { GEO(); unsigned char* ws = PWS(); float* out = POUT(); sample_mlpout(L, lds, (const bf16_t*)(ws + WS_HS), out + O_YS, vcu, G, wave, lane); }
        }
        SEAM(pb + 4);
    }
#pragma unroll 1
    for (int j = 0; j < 2; ++j) {
        const int pb = 11 + 5 * j, L = 2 + j;
        if (IN(pb)) {
            if (KON(6)) for (int rp_ = 0; rp_ < NREP(6); ++rp_) { const int G = gridDim.x, bx = opaque_bid(); unsigned char* ws = PWS(); float* out = POUT(); float* PS = (float*)(ws + WS_PS);
                const int N = (j == 0) ? 1536 : 1024;
                pg8::Gemm g{(const bf16_t*)(ws + WS_XB), (const bf16_t*)(ws + (j == 0 ? WS_WQKV : WS_WQ1)), MP, N, 1024}; pg8::StaticOrder S; S.init(MP, N, G, bx);
                pg8::EpiQKV E{(bf16_t*)(ws + WS_Q), (bf16_t*)(ws + WS_K), (bf16_t*)(ws + WS_V), PS, PIN(23) + j * 64, PIN(21), (const float*)(ws + WS_ROPE), out + O_KP, out + O_VP, 4};
                pg8::gemm_phase<pg8::EpiQKV, pg8::StaticOrder, true, true>(lds, g, S, E); }
            if (KON(9)) for (int rp_ = 0; rp_ < NREP(10); ++rp_) { GEO(); unsigned char* ws = PWS(); float* out = POUT(); sample_qkv(j, lds, out + O_YS, (float*)(ws + WS_QS), vcu, G, wave, lane);
                if (MULTI == 0 && j == 0 && G == 256 && (vcu & 31) >= 16) cache_copy(PIN(4), PIN(5), out, ((vcu >> 5) * 16 + (vcu & 31) - 16) * 512 + tid, 128 * 512); }
        }
        SEAM(pb);
        if (IN(pb + 1)) {
            if (KON(7)) for (int rp_ = 0; rp_ < NREP(7); ++rp_) { GEO(); unsigned char* ws = PWS(); attn_prompt(lds, (const bf16_t*)(ws + WS_Q), (const bf16_t*)(ws + WS_K), (const bf16_t*)(ws + WS_V), (bf16_t*)(ws + WS_O), PIN(24) + j * 16, vcu, G, tid, wave, lane); }
            if (KON(9)) for (int rp_ = 0; rp_ < NREP(10); ++rp_) { GEO(); unsigned char* ws = PWS(); sample_attn(j, lds, (const float*)(ws + WS_QS), (float*)(ws + WS_OS), vcu, G, wave, lane); }
        }
        SEAM(pb + 1);
        if (IN(pb + 2)) {
            if (KON(5)) { const int G = gridDim.x, bx = opaque_bid(); unsigned char* ws = PWS(); float* out = POUT(); float* PS = (float*)(ws + WS_PS);
                pg8::Gemm g{(const bf16_t*)(ws + WS_O), (const bf16_t*)(ws + WS_WO) + (size_t)j * 1024 * 1024, MP, 1024, 1024}; pg8::StaticOrder S; S.init(MP, 1024, G, bx);
                pg8::EpiResid E{(bf16_t*)(ws + WS_XB), nullptr, PS};
                pg8::gemm_phase<pg8::EpiResid, pg8::StaticOrder, false, true>(lds, g, S, E); }
            if (KON(9)) { GEO(); unsigned char* ws = PWS(); float* out = POUT(); sample_oproj(j, lds, (const float*)(ws + WS_OS), out + O_YS, vcu, G, wave, lane); }
        }
        SEAM(pb + 2);
        if (IN(pb + 3)) {
            if (KON(4)) for (int rp_ = 0; rp_ < NREP(4); ++rp_) { const int G = gridDim.x, bx = opaque_bid(); unsigned char* ws = PWS(); float* PS = (float*)(ws + WS_PS);
                pg8::Gemm g{(const bf16_t*)(ws + WS_XB), (const bf16_t*)(ws + WS_WIN) + (size_t)L * 4096 * 1024, MP, 4096, 1024}; pg8::StaticOrder S; S.init(MP, 4096, G, bx);
                pg8::EpiMlpIn<4> E{(bf16_t*)(ws + WS_H), PS, __builtin_amdgcn_make_buffer_rsrc((void*)ws, (short)0, (int)WS_END, 0x00020000)};
                pg8::gemm_phase<pg8::EpiMlpIn<4>, pg8::StaticOrder, true, true>(lds, g, S, E); }
            if (KON(9)) for (int rp_ = 0; rp_ < NREP(10); ++rp_) { GEO(); unsigned char* ws = PWS(); float* out = POUT(); sample_mlpin(L, lds, out + O_YS, (bf16_t*)(ws + WS_HS), vcu, G, wave, lane); }
        }
        SEAM(pb + 3);
        if (IN(pb + 4)) {
            if (KON(5)) { const int G = gridDim.x, bx = opaque_bid(); unsigned char* ws = PWS(); float* out = POUT(); float* PS = (float*)(ws + WS_PS);
                pg8::Gemm g{(const bf16_t*)(ws + WS_H), (const bf16_t*)(ws + WS_WOUT) + (size_t)L * 1024 * 4096, MP, 1024, 4096}; pg8::StaticOrder S; S.init(MP, 1024, G, bx);
                pg8::EpiResid E{(bf16_t*)(ws + WS_XB), (j == 0) ? nullptr : out + O_YP, (j == 0) ? PS : nullptr};
                pg8::gemm_phase<pg8::EpiResid, pg8::StaticOrder, false, true>(lds, g, S, E); }
            if (KON(9)) { GEO(); unsigned char* ws = PWS(); float* out = POUT(); sample_mlpout(L, lds, (const bf16_t*)(ws + WS_HS), out + O_YS, vcu, G, wave, lane); }
        }
        SEAM(pb + 4);
    }
#undef IN
#undef SEAM
}

extern "C" void kernel_launch(void* const* d_in, const int* in_sizes, int n_in, void* d_out, int out_size, void* d_ws, size_t ws_size, hipStream_t stream) {
    static int ready = 0;
    if (!ready) {
        (void)hipFuncSetAttribute((const void*)yoco_fwd, hipFuncAttributeMaxDynamicSharedMemorySize, LDS_BYTES);
        int per_cu = 0; (void)hipOccupancyMaxActiveBlocksPerMultiprocessor(&per_cu, (const void*)yoco_fwd, NWAVES * 64, LDS_BYTES);
        if (ws_size < WS_END) fprintf(stderr, "kernel_launch: workspace too small: %zu < %zu\n", ws_size, (size_t)WS_END);
        if (per_cu < 1) fprintf(stderr, "kernel_launch: occupancy query reports %d blocks per CU\n", per_cu);
        (void)hipGetLastError();
        ready = 1;
    }
    Args a{};
    for (int i = 0; i < 28; ++i) a.in[i] = (const float*)d_in[i];
    a.out = (float*)d_out; a.ws = (unsigned char*)d_ws;
    for (int d = 0; d < 32; ++d) a.inv[d] = powf(10000.0f, -(float)d / 32.0f);
    const int grid = 256;
#if MULTI
    for (int p = 0; p < NPH_RUN; ++p) { a.ph_lo = p; a.ph_hi = p + 1; hipLaunchKernelGGL(yoco_fwd, dim3(grid), dim3(NWAVES * 64), LDS_BYTES, stream, a); }
#else
    a.ph_lo = 0; a.ph_hi = NPHASE;
    (void)hipMemsetAsync(d_ws, 0, 16384, stream);
    void* kargs[] = {&a};
    hipError_t e = hipLaunchCooperativeKernel((const void*)yoco_fwd, dim3(grid), dim3(NWAVES * 64), kargs, LDS_BYTES, stream);
    if (e != hipSuccess) fprintf(stderr, "cooperative launch failed: %s\n", hipGetErrorString(e));
#endif
}
```

```cpp
#include <hip/hip_runtime.h>
#include <hip/hip_cooperative_groups.h>
#include <cstdio>
#include <cstdint>
#include <cmath>
namespace cg = cooperative_groups;
#ifndef MULTI
#define MULTI 0
#endif
namespace pg8 {
#define PG8_LAS __attribute__((address_space(3)))
typedef unsigned short bf16_t;
typedef short bf16x8 __attribute__((ext_vector_type(8)));
typedef float f32x4 __attribute__((ext_vector_type(4)));
typedef unsigned u32x4 __attribute__((ext_vector_type(4)));
constexpr int BM = 256, BK = 64, HALF = 128, HTB = HALF * BK * 2  , STAGE_BYTES = 8 * HTB, NXCD = 8, WGM = 8;

__host__ __device__ __forceinline__ int lds_byte(int r, int c) { const int st = (r >> 4) * 2 + (c >> 5), rr = r & 15, cc = c & 31, ob = rr * 64 + cc * 2; return st * 1024 + (ob ^ (((ob >> 9) & 1) << 5)); }
__host__ __device__ __forceinline__ void stage_rc(int b, int& R, int& C) { const int st = b / 1024, sb = b % 1024, swz = sb ^ (((sb >> 9) & 1) << 5); R = (st >> 1) * 16 + swz / 64; C = (st & 1) * 32 + (swz % 64) / 2; }
__host__ __device__ __forceinline__ int perm32(int rho) { const int n = rho >> 4, i = rho & 15; return 8 * (i >> 2) + 4 * n + (i & 3); }

struct Unit { int pm, pn; };
struct Gemm { const bf16_t* A; const bf16_t* Bt; int M, N, K; };

struct StaticOrder {
    int nM, nN, nwg, G, c;
    __host__ __device__ void init(int M, int N, int G_, int c_) { nM = M / BM; nN = N / BM; nwg = nM * nN; G = G_; c = c_; }
    __host__ __device__ bool next(int i, Unit& u) const {
        const long L = (long)i * G + c; if (L >= nwg) return false;
        int wgid = (int)L; { const int q = nwg / NXCD, r = nwg % NXCD, xcd = wgid % NXCD, off = wgid / NXCD; wgid = (xcd < r ? xcd * (q + 1) : r * (q + 1) + (xcd - r) * q) + off; }
        const int nig = WGM * nN, gid = wgid / nig, fm = gid * WGM, gsz = (nM - fm) < WGM ? (nM - fm) : WGM;
        u.pm = fm + ((wgid % nig) % gsz); u.pn = (wgid % nig) / gsz; return true;
    }
    __device__ __forceinline__ void a_ready(const Unit&) const {}
    __device__ __forceinline__ void done(const Unit&) const {}
};

__device__ __forceinline__ unsigned cvt_pk_bf16(float lo, float hi) { unsigned r; asm volatile("v_cvt_pk_bf16_f32 %0, %1, %2" : "=v"(r) : "v"(lo), "v"(hi)); return r; }
typedef float f32x2 __attribute__((ext_vector_type(2)));
template <class Epi, class Sched, bool ALIGN_EPI = false, bool SP2 = false>
__device__ __forceinline__ void gemm_phase(PG8_LAS unsigned char* lds, const Gemm g, const Sched& S, const Epi& E) {
    int tid_; asm volatile("v_mov_b32 %0, %1" : "=v"(tid_) : "v"((int)threadIdx.x)); const int tid = tid_, wid = __builtin_amdgcn_readfirstlane(tid >> 6), lane = tid & 63, wr = wid >> 2, wc = wid & 3, fr = lane & 15, fq = lane >> 4;
    const int K = g.K, nt = K / BK;
    unsigned voffA[2], voffB[2];
#pragma unroll
    for (int i = 0; i < 2; ++i) { int R, C; stage_rc(tid * 16 + i * 8192, R, C); const int Rb = Epi::PERM ? ((R & ~31) + perm32(R & 31)) : R;
        voffA[i] = (unsigned)(R * K + C) * 2u; voffB[i] = (unsigned)(Rb * K + C) * 2u; }
    const size_t kstep = (size_t)(BK * 2);
    const size_t hstep = (size_t)HALF * K * 2;
    const size_t tstep = 2 * hstep;
    const unsigned ldsw = (unsigned)wid * 1024u;
    const int aoff = lds_byte(wr * 64 + fr, fq * 8), boff = lds_byte(wc * 32 + fr, fq * 8);
#define PG8_SA(b, h) (((b) * 2 + (h)) * HTB)
#define PG8_SB(b, h) ((4 + (b) * 2 + (h)) * HTB)
#define PG8_STAGE(bufoff, gbase, voff) do { _Pragma("unroll") for (int _i = 0; _i < 2; ++_i) \
        __builtin_amdgcn_global_load_lds((const unsigned*)((const char*)(gbase) + (voff)[_i]), (PG8_LAS unsigned*)(lds + (bufoff) + ldsw + _i * 8192), 16, 0, 0); } while (0)
#define PG8_LDA(dst, b, h) do { _Pragma("unroll") for (int m = 0; m < 4; ++m) _Pragma("unroll") for (int k = 0; k < 2; ++k) dst[m][k] = *(const PG8_LAS bf16x8*)(lds + PG8_SA(b, h) + aoff + m * 2048 + k * 1024); } while (0)
#define PG8_LDB(dst, b, h) do { _Pragma("unroll") for (int n = 0; n < 2; ++n) _Pragma("unroll") for (int k = 0; k < 2; ++k) dst[n][k] = *(const PG8_LAS bf16x8*)(lds + PG8_SB(b, h) + boff + n * 2048 + k * 1024); } while (0)
#define PG8_MMA(ai, bj, At, Bt) do { __builtin_amdgcn_s_setprio(1); _Pragma("unroll") for (int m = 0; m < 4; ++m) _Pragma("unroll") for (int n = 0; n < 2; ++n) _Pragma("unroll") for (int k = 0; k < 2; ++k) \
        acc[ai][bj][m][n] = __builtin_amdgcn_mfma_f32_16x16x32_bf16(Bt[n][k], At[m][k], acc[ai][bj][m][n], 0, 0, 0); __builtin_amdgcn_s_setprio(0); } while (0)
#define PG8_WAIT_V(n) asm volatile("s_waitcnt vmcnt(" #n ")" ::: "memory")
#define PG8_WAIT_L(n) asm volatile("s_waitcnt lgkmcnt(" #n ")" ::: "memory")
#define PG8_BAR __builtin_amdgcn_s_barrier()
#define PG8_SCHED __builtin_amdgcn_sched_barrier(0)
    Unit cur, nxt; int ui = 0;
    if (!S.next(0, cur)) return;
    f32x4 acc[2][2][4][2];
#pragma unroll
    for (int a = 0; a < 2; ++a)
#pragma unroll
        for (int b = 0; b < 2; ++b)
#pragma unroll
            for (int m = 0; m < 4; ++m)
#pragma unroll
                for (int n = 0; n < 2; ++n) acc[a][b][m][n] = (f32x4){0.f, 0.f, 0.f, 0.f};
    bf16x8 At[4][2], B0[2][2], B1[2][2];
    const char* cA = (const char*)g.A + (size_t)cur.pm * tstep; const char* cB = (const char*)g.Bt + (size_t)cur.pn * tstep;
    S.a_ready(cur);
    if constexpr (SP2) {
        PG8_STAGE(PG8_SB(0, 0), cB, voffB); PG8_STAGE(PG8_SB(0, 1), cB + hstep, voffB); PG8_STAGE(PG8_SA(0, 0), cA, voffA); PG8_STAGE(PG8_SA(0, 1), cA + hstep, voffA);
        if (wr == 1) PG8_BAR;
        PG8_WAIT_V(2); PG8_BAR;
        PG8_STAGE(PG8_SB(1, 0), cB + kstep, voffB); PG8_STAGE(PG8_SA(1, 0), cA + kstep, voffA); PG8_STAGE(PG8_SB(1, 1), cB + hstep + kstep, voffB);
        PG8_WAIT_V(6); PG8_BAR;
    } else {
        PG8_STAGE(PG8_SB(0, 0), cB, voffB); PG8_STAGE(PG8_SA(0, 0), cA, voffA); PG8_STAGE(PG8_SB(0, 1), cB + hstep, voffB); PG8_STAGE(PG8_SA(0, 1), cA + hstep, voffA);
        if (wr == 1) PG8_BAR;
        PG8_WAIT_V(4); PG8_BAR;
        PG8_STAGE(PG8_SB(1, 0), cB + kstep, voffB); PG8_STAGE(PG8_SA(1, 0), cA + kstep, voffA); PG8_STAGE(PG8_SB(1, 1), cB + hstep + kstep, voffB);
        PG8_WAIT_V(6); PG8_BAR;
    }
    for (;;) {
        const bool has_next = S.next(ui + 1, nxt);
        const char* nA = has_next ? (const char*)g.A + (size_t)nxt.pm * tstep : cA; const char* nB = has_next ? (const char*)g.Bt + (size_t)nxt.pn * tstep : cB;
        for (int t = 0; t < nt; t += 2) {
            const bool last = (t == nt - 2);
            const char* a1 = cA + (size_t)(t + 1) * kstep;
            const char* a2 = last ? nA : cA + (size_t)(t + 2) * kstep; const char* b2 = last ? nB : cB + (size_t)(t + 2) * kstep;
            const char* a3 = a2 + kstep; const char* b3 = b2 + kstep;
            if (last && has_next) S.a_ready(nxt);
            if constexpr (SP2) {
            PG8_LDB(B0, 0, 0); PG8_LDB(B1, 0, 1); PG8_SCHED; PG8_LDA(At, 0, 0); PG8_STAGE(PG8_SA(1, 1), a1 + hstep, voffA);
            PG8_WAIT_V(8); PG8_WAIT_L(0); PG8_BAR; PG8_MMA(0, 0, At, B0); PG8_MMA(0, 1, At, B1); PG8_BAR; PG8_SCHED;
            PG8_LDA(At, 0, 1); PG8_STAGE(PG8_SB(0, 0), b2, voffB); PG8_STAGE(PG8_SB(0, 1), b2 + hstep, voffB); PG8_STAGE(PG8_SA(0, 0), a2, voffA);
            PG8_WAIT_V(8); PG8_WAIT_L(0); PG8_BAR; PG8_MMA(1, 0, At, B0); PG8_MMA(1, 1, At, B1); PG8_BAR; PG8_SCHED;
            PG8_LDB(B0, 1, 0); PG8_LDB(B1, 1, 1); PG8_SCHED; PG8_LDA(At, 1, 0); PG8_STAGE(PG8_SA(0, 1), a2 + hstep, voffA);
            PG8_WAIT_V(8); PG8_WAIT_L(0); PG8_BAR; PG8_MMA(0, 0, At, B0); PG8_MMA(0, 1, At, B1); PG8_BAR; PG8_SCHED;
            PG8_LDA(At, 1, 1); PG8_STAGE(PG8_SB(1, 0), b3, voffB); PG8_STAGE(PG8_SB(1, 1), b3 + hstep, voffB); PG8_STAGE(PG8_SA(1, 0), a3, voffA);
            PG8_WAIT_V(8); PG8_WAIT_L(0); PG8_BAR; PG8_MMA(1, 0, At, B0); PG8_MMA(1, 1, At, B1); PG8_BAR; PG8_SCHED;
            } else {
            PG8_LDB(B0, 0, 0); PG8_SCHED; PG8_LDA(At, 0, 0); PG8_STAGE(PG8_SA(1, 1), a1 + hstep, voffA);
            PG8_WAIT_L(8); PG8_BAR; PG8_WAIT_L(0); PG8_MMA(0, 0, At, B0); PG8_BAR; PG8_SCHED;
            PG8_LDB(B1, 0, 1); PG8_STAGE(PG8_SB(0, 0), b2, voffB);
            PG8_BAR; PG8_WAIT_L(0); PG8_MMA(0, 1, At, B1); PG8_BAR;
            PG8_LDA(At, 0, 1); PG8_STAGE(PG8_SA(0, 0), a2, voffA);
            PG8_BAR; PG8_WAIT_L(0); PG8_MMA(1, 0, At, B0); PG8_BAR; PG8_SCHED;
            PG8_STAGE(PG8_SB(0, 1), b2 + hstep, voffB);
            PG8_WAIT_V(6); PG8_BAR; PG8_MMA(1, 1, At, B1); PG8_BAR;
            PG8_LDB(B0, 1, 0); PG8_SCHED; PG8_LDA(At, 1, 0); PG8_STAGE(PG8_SA(0, 1), a2 + hstep, voffA);
            PG8_WAIT_L(8); PG8_BAR; PG8_WAIT_L(0); PG8_MMA(0, 0, At, B0); PG8_BAR; PG8_SCHED;
            PG8_LDB(B1, 1, 1); PG8_STAGE(PG8_SB(1, 0), b3, voffB);
            PG8_BAR; PG8_WAIT_L(0); PG8_MMA(0, 1, At, B1); PG8_BAR;
            PG8_LDA(At, 1, 1); PG8_STAGE(PG8_SA(1, 0), a3, voffA);
            PG8_BAR; PG8_WAIT_L(0); PG8_MMA(1, 0, At, B0); PG8_BAR; PG8_SCHED;
            PG8_STAGE(PG8_SB(1, 1), b3 + hstep, voffB);
            PG8_WAIT_V(6); PG8_BAR; PG8_MMA(1, 1, At, B1); PG8_BAR;
            }
        }
        if constexpr (ALIGN_EPI) { if (wr == 0) PG8_BAR; }
        if constexpr (!Epi::AFTER_DRAIN) { E(acc, cur, wr, wc, fr, fq); S.done(cur); }
        if (!has_next) break;
#pragma unroll
        for (int a = 0; a < 2; ++a)
#pragma unroll
            for (int b = 0; b < 2; ++b)
#pragma unroll
                for (int m = 0; m < 4; ++m)
#pragma unroll
                    for (int n = 0; n < 2; ++n) acc[a][b][m][n] = (f32x4){0.f, 0.f, 0.f, 0.f};
        cur = nxt; cA = nA; cB = nB; ++ui;
        if constexpr (ALIGN_EPI) { if (wr == 1) PG8_BAR; }
    }
    PG8_WAIT_V(0);
    if constexpr (!ALIGN_EPI) { if (wr == 0) PG8_BAR; }
    PG8_BAR;
    if constexpr (Epi::AFTER_DRAIN) { E.fused(acc, cur, wr, wc, fr, fq, lds, wid, lane); S.done(cur); }
#undef PG8_SA
#undef PG8_SB
#undef PG8_STAGE
#undef PG8_LDA
#undef PG8_LDB
#undef PG8_MMA
#undef PG8_WAIT_V
#undef PG8_WAIT_L
#undef PG8_BAR
#undef PG8_SCHED
}
}

#define DEVI __device__ __forceinline__
#define LAS __attribute__((address_space(3)))
typedef unsigned short bf16_t;
typedef short bf16x8 __attribute__((ext_vector_type(8)));
typedef float f32x4 __attribute__((ext_vector_type(4)));
typedef float f32x16 __attribute__((ext_vector_type(16)));
typedef unsigned u32x4 __attribute__((ext_vector_type(4)));
typedef unsigned u32x2 __attribute__((ext_vector_type(2)));

constexpr int D = 1024, SEQ = 4096, NB = 4, MP = NB * SEQ, NS = 128, FF = 4096;
constexpr float EPS = 1e-6f, LOG2E = 1.4426950408889634f;
constexpr float QSCALE = 0.125f * 1.4426950408889634f;
constexpr int NWAVES = 8;
constexpr int LDS_BYTES = 131072 + 1024;

constexpr size_t O_YP = 0, O_YS = 16777216, O_SPRE = 16908288, O_SPIM = 16941056, O_KP = 16973824, O_VP = 17104896,
                 O_SSRE = 17235968, O_SSIM = 18284544, O_KS = 19333120, O_VS = 23527424;
constexpr size_t MiB = 1u << 20, KiB = 1024;
constexpr size_t WS_WGLU = 1 * MiB, WS_WQKV = 9 * MiB, WS_WQ1 = 12 * MiB, WS_WO = 14 * MiB, WS_WIN = 18 * MiB, WS_WOUT = 50 * MiB;
constexpr size_t WS_LAM = 82 * MiB, WS_BBAR = WS_LAM + 64 * KiB, WS_CMAT = WS_BBAR + 512 * KiB, WS_ROPE = WS_CMAT + 512 * KiB;
constexpr size_t WS_SS = 84 * MiB + 512 * KiB;
constexpr size_t WS_GS = 85 * MiB, WS_QS = WS_GS + 512 * KiB, WS_OS = WS_QS + 512 * KiB, WS_HS = WS_OS + 512 * KiB;
constexpr size_t WS_XB = 89 * MiB, WS_K = 121 * MiB, WS_V = 129 * MiB, WS_H = 137 * MiB;
constexpr size_t WS_G = WS_H, WS_Q = WS_H, WS_O = WS_H + 32 * MiB, WS_E = WS_H + 64 * MiB;
constexpr size_t WS_PS = 265 * MiB;
constexpr size_t WS_END = 267 * MiB;
static_assert(WS_ROPE + 4097 * 64 * 4 <= WS_SS, "tables");

DEVI unsigned pkbf(float lo, float hi) { unsigned r; asm volatile("v_cvt_pk_bf16_f32 %0, %1, %2" : "=v"(r) : "v"(lo), "v"(hi)); return r; }
DEVI float wave_sum(float v) {
#pragma unroll
    for (int o = 1; o < 64; o <<= 1) v += __shfl_xor(v, o);
    return v;
}
DEVI float wave_max(float v) {
#pragma unroll
    for (int o = 1; o < 64; o <<= 1) v = fmaxf(v, __shfl_xor(v, o));
    return v;
}
DEVI void sincos_ang(float ang, float& s, float& c) {
    double t = (double)ang * 0.15915494309189535; t -= floor(t); const float f = (float)t;
    s = __builtin_amdgcn_sinf(f); c = __builtin_amdgcn_cosf(f);
}
DEVI float gelu_tanh(float y) {
    const float z2 = 1.5957691216057308f * (y + 0.044715f * y * y * y);
    return y * __builtin_amdgcn_rcpf(1.0f + __expf(-z2));
}
DEVI float sigmoidf_(float g) { return __builtin_amdgcn_rcpf(1.0f + __expf(-g)); }
constexpr int PT_OFF = 131072;
DEVI unsigned long long ldp_raw(int k) {
    unsigned long long v; const unsigned addr = PT_OFF + 8 * k;
    asm volatile("ds_read_b64 %0, %1\n\ts_waitcnt lgkmcnt(0)" : "=v"(v) : "v"(addr) : "memory");
    const unsigned lo = __builtin_amdgcn_readfirstlane((unsigned)v), hi = __builtin_amdgcn_readfirstlane((unsigned)(v >> 32));
    return ((unsigned long long)hi << 32) | lo;
}
#define GAS1 __attribute__((address_space(1)))
#define PIN(k) ((const float*)(const GAS1 float*)ldp_raw(k))
#define POUT() ((float*)(GAS1 float*)ldp_raw(28))
#define PWS() ((unsigned char*)(GAS1 unsigned char*)ldp_raw(29))

template <int NV> DEVI float row_ss(const float* ps, int row) {
    float s = 0.f;
#pragma unroll
    for (int i = 0; i < NV; ++i) { const f32x4 v = *(const f32x4*)(ps + (size_t)row * 32 + 4 * i); s += (v[0] + v[1]) + (v[2] + v[3]); }
    return s;
}
template <int NV> DEVI void row_ld(f32x4 (&pf)[NV], const float* ps, int row) {
#pragma unroll
    for (int i = 0; i < NV; ++i) pf[i] = *(const f32x4*)(ps + (size_t)row * 32 + 4 * i);
}
template <int NV> DEVI float row_sum(const f32x4 (&pf)[NV]) {
    float s = 0.f;
#pragma unroll
    for (int i = 0; i < NV; ++i) s += (pf[i][0] + pf[i][1]) + (pf[i][2] + pf[i][3]);
    return s;
}
DEVI float row_ss_rt(const float* ps, size_t row, int nv) {
    float s = 0.f;
    for (int i = 0; i < nv; ++i) { const f32x4 v = *(const f32x4*)(ps + row * 32 + 4 * i); s += (v[0] + v[1]) + (v[2] + v[3]); }
    return s;
}
#define WT_STORE16(w, rsrc, off) __builtin_amdgcn_raw_buffer_store_b128((w), (rsrc), (unsigned)(off), 0, 16)
namespace pg8 {
typedef unsigned u32x2 __attribute__((ext_vector_type(2)));
DEVI f32x4 bf4_to_f32(u32x2 w) { f32x4 r; r[0] = __uint_as_float(w.x << 16); r[1] = __uint_as_float(w.x & 0xffff0000u); r[2] = __uint_as_float(w.y << 16); r[3] = __uint_as_float(w.y & 0xffff0000u); return r; }
struct EpiResid {
    static constexpr bool PERM = true, AFTER_DRAIN = false;
    bf16_t* xb; float* outf; float* ss;
    __device__ __forceinline__ void operator()(const f32x4 (&acc)[2][2][4][2], const Unit& u, int wr, int wc, int fr, int fq) const {
        const int col0 = u.pn * BM + wc * 32 + 8 * fq;
        u32x4 pb[2];
#pragma unroll
        for (int bj = 0; bj < 2; ++bj) pb[bj] = *(const u32x4*)(xb + (size_t)(u.pm * BM + wr * 64 + fr) * 1024 + col0 + bj * HALF);
#pragma unroll
        for (int ai = 0; ai < 2; ++ai)
#pragma unroll
            for (int m = 0; m < 4; ++m) {
                const int row = u.pm * BM + ai * HALF + wr * 64 + m * 16 + fr;
                const size_t off = (size_t)row * 1024 + col0;
                const u32x4 cb0 = pb[0], cb1 = pb[1];
                if (ai * 4 + m < 7) { const int t1 = ai * 4 + m + 1; const size_t o1 = (size_t)(u.pm * BM + (t1 >> 2) * HALF + wr * 64 + (t1 & 3) * 16 + fr) * 1024 + col0;
#pragma unroll
                    for (int bj = 0; bj < 2; ++bj) pb[bj] = *(const u32x4*)(xb + o1 + bj * HALF); }
                asm volatile("" ::: "memory");
                float s = 0.f;
#pragma unroll
                for (int bj = 0; bj < 2; ++bj) {
                    const u32x4 cb = bj ? cb1 : cb0;
                    const size_t o = off + bj * HALF;
                    const f32x4 v0 = bf4_to_f32((u32x2){cb.x, cb.y}) + acc[ai][bj][m][0], v1 = bf4_to_f32((u32x2){cb.z, cb.w}) + acc[ai][bj][m][1];
                    if (outf) { *(f32x4*)(outf + o) = v0; *(f32x4*)(outf + o + 4) = v1; }
                    else { u32x4 w; w.x = cvt_pk_bf16(v0[0], v0[1]); w.y = cvt_pk_bf16(v0[2], v0[3]); w.z = cvt_pk_bf16(v1[0], v1[1]); w.w = cvt_pk_bf16(v1[2], v1[3]); *(u32x4*)(xb + o) = w; }
                    s += ((v0[0] * v0[0] + v0[1] * v0[1]) + (v0[2] * v0[2] + v0[3] * v0[3])) + ((v1[0] * v1[0] + v1[1] * v1[1]) + (v1[2] * v1[2] + v1[3] * v1[3]));
                }
                if (ss) { s += __shfl_xor(s, 16); s += __shfl_xor(s, 32); if (fq == 0) ss[(size_t)row * 32 + u.pn * 4 + wc] = s; }
                asm volatile("" ::: "memory");
            }
    }
};
struct EpiGlu {
    static constexpr bool PERM = true, AFTER_DRAIN = false;
    bf16_t* xb; float* ss; const float* bias;
    __device__ __forceinline__ void operator()(const f32x4 (&acc)[2][2][4][2], const Unit& u, int wr, int wc, int fr, int fq) const {
        const int c0 = u.pn * 128 + wc * 32 + 8 * fq;
        f32x4 bv[2], bg[2];
#pragma unroll
        for (int n = 0; n < 2; ++n) { bv[n] = *(const f32x4*)(bias + c0 + 4 * n); bg[n] = *(const f32x4*)(bias + 1024 + c0 + 4 * n); }
        u32x4 pb = *(const u32x4*)(xb + (size_t)(u.pm * BM + wr * 64 + fr) * 1024 + c0);
#pragma unroll
        for (int ai = 0; ai < 2; ++ai)
#pragma unroll
            for (int m = 0; m < 4; ++m) {
                const int row = u.pm * BM + ai * HALF + wr * 64 + m * 16 + fr;
                const u32x4 cb = pb;
                if (ai * 4 + m < 7) { const int t1 = ai * 4 + m + 1; pb = *(const u32x4*)(xb + (size_t)(u.pm * BM + (t1 >> 2) * HALF + wr * 64 + (t1 & 3) * 16 + fr) * 1024 + c0); }
                asm volatile("" ::: "memory");
                const size_t o = (size_t)row * 1024 + c0;
                f32x4 v[2] = {bf4_to_f32((u32x2){cb.x, cb.y}), bf4_to_f32((u32x2){cb.z, cb.w})};
                float s = 0.f;
#pragma unroll
                for (int n = 0; n < 2; ++n) {
                    const f32x4 val = acc[ai][0][m][n] + bv[n], gt = acc[ai][1][m][n] + bg[n];
#pragma unroll
                    for (int e = 0; e < 4; ++e) v[n][e] += val[e] * __builtin_amdgcn_rcpf(1.0f + __expf(-gt[e]));
                    s += (v[n][0] * v[n][0] + v[n][1] * v[n][1]) + (v[n][2] * v[n][2] + v[n][3] * v[n][3]);
                }
                u32x4 w; w.x = cvt_pk_bf16(v[0][0], v[0][1]); w.y = cvt_pk_bf16(v[0][2], v[0][3]); w.z = cvt_pk_bf16(v[1][0], v[1][1]); w.w = cvt_pk_bf16(v[1][2], v[1][3]);
                *(u32x4*)(xb + o) = w;
                s += __shfl_xor(s, 16); s += __shfl_xor(s, 32); if (fq == 0) ss[(size_t)row * 32 + u.pn * 4 + wc] = s;
                asm volatile("" ::: "memory");
            }
    }
};
template <int NV> struct EpiMlpIn {
    static constexpr bool PERM = true, AFTER_DRAIN = false;
    bf16_t* H; const float* ss; __amdgpu_buffer_rsrc_t wsr;
    __device__ __forceinline__ void operator()(const f32x4 (&acc)[2][2][4][2], const Unit& u, int wr, int wc, int fr, int fq) const {
        const int col0 = u.pn * BM + wc * 32 + 8 * fq;
        f32x4 pf[NV]; row_ld<NV>(pf, ss, u.pm * BM + wr * 64 + fr);
#pragma unroll
        for (int ai = 0; ai < 2; ++ai)
#pragma unroll
            for (int m = 0; m < 4; ++m) {
                const int row = u.pm * BM + ai * HALF + wr * 64 + m * 16 + fr;
                const float rs = rsqrtf(row_sum<NV>(pf) * (1.0f / 1024.0f) + 1e-6f);
                if (ai * 4 + m < 7) { const int t1 = ai * 4 + m + 1; row_ld<NV>(pf, ss, u.pm * BM + (t1 >> 2) * HALF + wr * 64 + (t1 & 3) * 16 + fr); }
                asm volatile("" ::: "memory");
                bf16_t* rowp = H + (size_t)row * 4096 + col0;
#pragma unroll
                for (int bj = 0; bj < 2; ++bj) {
                    f32x4 v0 = acc[ai][bj][m][0] * rs, v1 = acc[ai][bj][m][1] * rs;
#pragma unroll
                    for (int e = 0; e < 4; ++e) { const float a = fmaxf(v0[e], 0.f), b = fmaxf(v1[e], 0.f); v0[e] = a * a; v1[e] = b * b; }
                    u32x4 w; w.x = cvt_pk_bf16(v0[0], v0[1]); w.y = cvt_pk_bf16(v0[2], v0[3]); w.z = cvt_pk_bf16(v1[0], v1[1]); w.w = cvt_pk_bf16(v1[2], v1[3]);
                    WT_STORE16(w, wsr, WS_H + ((size_t)row * 4096 + col0 + bj * HALF) * 2);
                }
                asm volatile("" ::: "memory");
            }
    }
};
struct EpiQKV {
    static constexpr bool PERM = true, AFTER_DRAIN = false;
    bf16_t *Q, *Kb, *Vb; const float* ss; const float* qg; const float* kg; const float* rope; float* outk; float* outv; int nq;
    __device__ __forceinline__ void operator()(const f32x4 (&acc)[2][2][4][2], const Unit& u, int wr, int wc, int fr, int fq) const {
        const int d0 = 8 * fq;
        if (u.pn <= nq) {
            const bool isq = u.pn < nq; const float* gn = isq ? qg : kg; const float sc = isq ? (0.125f * 1.4426950408889634f) : 1.0f;
            f32x4 g[2][2];
#pragma unroll
            for (int bj = 0; bj < 2; ++bj)
#pragma unroll
                for (int n = 0; n < 2; ++n) g[bj][n] = *(const f32x4*)(gn + 32 * bj + d0 + 4 * n) * sc;
            f32x4 pf[4]; row_ld<4>(pf, ss, u.pm * BM + wr * 64 + fr);
#pragma unroll
            for (int ai = 0; ai < 2; ++ai)
#pragma unroll
                for (int m = 0; m < 4; ++m) {
                    const int row = u.pm * BM + ai * HALF + wr * 64 + m * 16 + fr;
                    const float rs = rsqrtf(row_sum<4>(pf) * (1.0f / 1024.0f) + 1e-6f);
                    if (ai * 4 + m < 7) { const int t1 = ai * 4 + m + 1; row_ld<4>(pf, ss, u.pm * BM + (t1 >> 2) * HALF + wr * 64 + (t1 & 3) * 16 + fr); }
                    asm volatile("" ::: "memory");
                    const int pos = row & 4095;
                    f32x4 v[2][2]; float s = 0.f;
#pragma unroll
                    for (int bj = 0; bj < 2; ++bj)
#pragma unroll
                        for (int n = 0; n < 2; ++n) { v[bj][n] = acc[ai][bj][m][n] * rs; s += (v[bj][n][0] * v[bj][n][0] + v[bj][n][1] * v[bj][n][1]) + (v[bj][n][2] * v[bj][n][2] + v[bj][n][3] * v[bj][n][3]); }
                    s += __shfl_xor(s, 16); s += __shfl_xor(s, 32);
                    const float rn = rsqrtf(s * (1.0f / 64.0f) + 1e-6f);
                    f32x4 lo[2], hi[2];
#pragma unroll
                    for (int n = 0; n < 2; ++n) {
                        const f32x4 cs = *(const f32x4*)(rope + (size_t)pos * 64 + d0 + 4 * n), sn = *(const f32x4*)(rope + (size_t)pos * 64 + 32 + d0 + 4 * n);
                        const f32x4 x1 = v[0][n] * rn * g[0][n], x2 = v[1][n] * rn * g[1][n];
                        lo[n] = x1 * cs - x2 * sn; hi[n] = x2 * cs + x1 * sn;
                    }
                    bf16_t* dst = isq ? (Q + (size_t)row * 1024 + (4 * u.pn + wc) * 64 + d0) : (Kb + (size_t)row * 256 + wc * 64 + d0);
                    u32x4 w; w.x = cvt_pk_bf16(lo[0][0], lo[0][1]); w.y = cvt_pk_bf16(lo[0][2], lo[0][3]); w.z = cvt_pk_bf16(lo[1][0], lo[1][1]); w.w = cvt_pk_bf16(lo[1][2], lo[1][3]);
                    *(u32x4*)dst = w;
                    w.x = cvt_pk_bf16(hi[0][0], hi[0][1]); w.y = cvt_pk_bf16(hi[0][2], hi[0][3]); w.z = cvt_pk_bf16(hi[1][0], hi[1][1]); w.w = cvt_pk_bf16(hi[1][2], hi[1][3]);
                    *(u32x4*)(dst + 32) = w;
                    if (!isq && pos >= 3968) {
                        float* ok = outk + ((size_t)((row >> 12) * 128 + (pos - 3968)) * 4 + wc) * 64 + d0;
                        *(f32x4*)ok = lo[0]; *(f32x4*)(ok + 4) = lo[1]; *(f32x4*)(ok + 32) = hi[0]; *(f32x4*)(ok + 36) = hi[1];
                    }
                    asm volatile("" ::: "memory");
                }
        } else {
            const int col0 = wc * 32 + 8 * fq;
            f32x4 pf[4]; row_ld<4>(pf, ss, u.pm * BM + wr * 64 + fr);
#pragma unroll
            for (int ai = 0; ai < 2; ++ai)
#pragma unroll
                for (int m = 0; m < 4; ++m) {
                    const int row = u.pm * BM + ai * HALF + wr * 64 + m * 16 + fr;
                    const float rs = rsqrtf(row_sum<4>(pf) * (1.0f / 1024.0f) + 1e-6f);
                    if (ai * 4 + m < 7) { const int t1 = ai * 4 + m + 1; row_ld<4>(pf, ss, u.pm * BM + (t1 >> 2) * HALF + wr * 64 + (t1 & 3) * 16 + fr); }
                    asm volatile("" ::: "memory");
                    const int pos = row & 4095;
#pragma unroll
                    for (int bj = 0; bj < 2; ++bj) {
                        const f32x4 v0 = acc[ai][bj][m][0] * rs, v1 = acc[ai][bj][m][1] * rs;
                        u32x4 w; w.x = cvt_pk_bf16(v0[0], v0[1]); w.y = cvt_pk_bf16(v0[2], v0[3]); w.z = cvt_pk_bf16(v1[0], v1[1]); w.w = cvt_pk_bf16(v1[2], v1[3]);
                        *(u32x4*)(Vb + (size_t)row * 256 + bj * HALF + col0) = w;
                        if (pos >= 3968) { float* ov = outv + (size_t)((row >> 12) * 128 + (pos - 3968)) * 256 + bj * HALF + col0; *(f32x4*)ov = v0; *(f32x4*)(ov + 4) = v1; }
                    }
                    asm volatile("" ::: "memory");
                }
        }
    }
};
}

DEVI unsigned f2bf(float f) { unsigned u = __builtin_bit_cast(unsigned, f); return (u + 0x7fffu + ((u >> 16) & 1u)) >> 16; }
DEVI unsigned pk2(float lo, float hi) { return f2bf(lo) | (f2bf(hi) << 16); }
DEVI int wt_row(int mode, int c) {
    if (mode == 1) { return c < 1024 ? (256 * (c >> 7) + (c & 127)) : (256 * ((c - 1024) >> 7) + 128 + (c & 127)); }
    if (mode == 2) { const int hd = c >> 6, dd = c & 32; return 256 * (hd >> 2) + 4 * dd + 32 * (hd & 3); }
    return c;
}
DEVI void transpose_item(const float* W, int K, int N, bf16_t* WT, int row_off, int mode, const float* gain, LAS float* scr, int item, int lane) {
    const int nblk = N / 32, kb = item / nblk, nb = item % nblk, k0 = 64 * kb, n0 = 32 * nb;
    f32x4 wv[8];
#pragma unroll
    for (int i = 0; i < 8; ++i) wv[i] = *(const f32x4*)(W + (size_t)(k0 + 8 * i + (lane >> 3)) * N + n0 + 4 * (lane & 7));
#pragma unroll
    for (int i = 0; i < 8; ++i) { const int kk = 8 * i + (lane >> 3); const float gk = gain ? gain[k0 + kk] : 1.0f; LAS float* d = scr + kk * 33 + 4 * (lane & 7);
        d[0] = wv[i][0] * gk; d[1] = wv[i][1] * gk; d[2] = wv[i][2] * gk; d[3] = wv[i][3] * gk; }
    asm volatile("s_waitcnt lgkmcnt(0)" ::: "memory");
    const int c = lane & 7; const int rb = row_off + wt_row(mode, n0);
#pragma unroll
    for (int j = 0; j < 4; ++j) { const int n = (lane >> 3) + 8 * j; const LAS float* s = scr + (8 * c) * 33 + n;
        u32x4 o; o.x = pk2(s[0 * 33], s[1 * 33]); o.y = pk2(s[2 * 33], s[3 * 33]); o.z = pk2(s[4 * 33], s[5 * 33]); o.w = pk2(s[6 * 33], s[7 * 33]);
        *(u32x4*)(WT + (size_t)(rb + n) * K + k0 + 8 * c) = o; }
    asm volatile("s_waitcnt lgkmcnt(0)" ::: "memory");
}

DEVI void cache_copy(const float* ck, const float* cv, float* out, int first, int nthr) {
    for (int i0 = first; i0 < NS * 127 * 64; i0 += 4 * nthr) {
        f32x4 kv4[4], vv4[4]; size_t dst[4];
#pragma unroll
        for (int t = 0; t < 4; ++t) { const int i = i0 + t * nthr; const bool ok = i < NS * 127 * 64; const int ii = ok ? i : 0; const int b = ii / (127 * 64), rem = ii % (127 * 64);
            dst[t] = ok ? ((size_t)b * 128 * 64 + rem) : (size_t)-1;
            kv4[t] = ((const f32x4*)ck)[(size_t)b * 128 * 64 + 64 + rem]; vv4[t] = ((const f32x4*)cv)[(size_t)b * 128 * 64 + 64 + rem]; }
#pragma unroll
        for (int t = 0; t < 4; ++t) if (dst[t] != (size_t)-1) { ((f32x4*)(out + O_KS))[dst[t]] = kv4[t]; ((f32x4*)(out + O_VS))[dst[t]] = vv4[t]; }
    }
}

struct Args { const float* in[28]; float* out; unsigned char* ws; float inv[32]; int ph_lo, ph_hi; };

DEVI void prologue(const Args& a, LAS unsigned char* lds, int vcu, int G, int tid, int wave, int lane) {
    unsigned char* ws = a.ws;
    LAS float* scr = (LAS float*)(lds + wave * 16384);
    const int gw = vcu * NWAVES + wave, NGW = G * NWAVES;
    constexpr int I_GLU = 16 * 64, I_Q = 16 * 32, I_KV = 16 * 8, I_O = 16 * 32, I_IN = 16 * 128, I_OUT = 64 * 32;
    constexpr int NITEMS = 2 * I_GLU + 2 * I_Q + 2 * I_KV + 2 * I_O + 4 * I_IN + 4 * I_OUT;
    const float* nmix = a.in[6]; const float* nmlp = a.in[7]; const float* nkv = a.in[18];
    for (int it = gw; it < NITEMS; it += NGW) {
        int r = it;
        if (r < 2 * I_GLU) { const int l = r / I_GLU; transpose_item(a.in[16] + (size_t)l * 1024 * 2048, 1024, 2048, (bf16_t*)(ws + WS_WGLU) + (size_t)l * 2048 * 1024, 0, 1, nullptr, scr, r % I_GLU, lane); continue; } r -= 2 * I_GLU;
        if (r < I_Q) { transpose_item(a.in[22], 1024, 1024, (bf16_t*)(ws + WS_WQKV), 0, 2, nmix + 2 * 1024, scr, r, lane); continue; } r -= I_Q;
        if (r < I_Q) { transpose_item(a.in[22] + 1024 * 1024, 1024, 1024, (bf16_t*)(ws + WS_WQ1), 0, 2, nmix + 3 * 1024, scr, r, lane); continue; } r -= I_Q;
        if (r < I_KV) { transpose_item(a.in[19], 1024, 256, (bf16_t*)(ws + WS_WQKV), 1024, 2, nkv, scr, r, lane); continue; } r -= I_KV;
        if (r < I_KV) { transpose_item(a.in[20], 1024, 256, (bf16_t*)(ws + WS_WQKV), 1280, 0, nkv, scr, r, lane); continue; } r -= I_KV;
        if (r < 2 * I_O) { const int l = r / I_O; transpose_item(a.in[25] + (size_t)l * 1024 * 1024, 1024, 1024, (bf16_t*)(ws + WS_WO) + (size_t)l * 1024 * 1024, 0, 0, nullptr, scr, r % I_O, lane); continue; } r -= 2 * I_O;
        if (r < 4 * I_IN) { const int l = r / I_IN; transpose_item(a.in[26] + (size_t)l * 1024 * 4096, 1024, 4096, (bf16_t*)(ws + WS_WIN) + (size_t)l * 4096 * 1024, 0, 0, nmlp + l * 1024, scr, r % I_IN, lane); continue; } r -= 4 * I_IN;
        { const int l = r / I_OUT; transpose_item(a.in[27] + (size_t)l * 4096 * 1024, 4096, 1024, (bf16_t*)(ws + WS_WOUT) + (size_t)l * 1024 * 4096, 0, 0, nullptr, scr, r % I_OUT, lane); }
    }
    float* PS = (float*)(ws + WS_PS);
    for (int m0 = 4 * gw; m0 < MP; m0 += 4 * NGW) {
        f32x4 xv[4][4];
#pragma unroll
        for (int rr = 0; rr < 4; ++rr)
#pragma unroll
            for (int j = 0; j < 4; ++j) xv[rr][j] = ((const f32x4*)(a.in[0] + (size_t)(m0 + rr) * 1024) + lane)[64 * j];
#pragma unroll
        for (int rr = 0; rr < 4; ++rr) { const int m = m0 + rr; float s = 0.f;
#pragma unroll
            for (int j = 0; j < 4; ++j) { const f32x4 v = xv[rr][j]; s += (v[0] * v[0] + v[1] * v[1]) + (v[2] * v[2] + v[3] * v[3]);
                u32x2 w; w.x = pkbf(v[0], v[1]); w.y = pkbf(v[2], v[3]); *(u32x2*)((bf16_t*)(ws + WS_XB) + (size_t)m * 1024 + 4 * lane + 256 * j) = w; }
            s = wave_sum(s); if (lane < 4) *(f32x4*)(PS + (size_t)m * 32 + 4 * lane) = (f32x4){lane == 0 ? s : 0.f, 0.f, 0.f, 0.f}; }
    }
    const int gt = vcu * 512 + tid, NT = G * 512;
    for (int i = gt; i < NS * 1024 / 4; i += NT) ((f32x4*)(a.out + O_YS))[i] = ((const f32x4*)a.in[1])[i];
    if (MULTI || G != 256) cache_copy(a.in[4], a.in[5], a.out, gt, NT);
    float* rope = (float*)(ws + WS_ROPE);
    for (int i = gt; i < 4097 * 32; i += NT) { const int pr = i >> 5, d = i & 31; const float pos = (pr == 4096) ? 8192.f : (float)pr; const float ang = pos * a.inv[d];
        float s, c; sincos_ang(ang, s, c); rope[(size_t)pr * 64 + d] = c; rope[(size_t)pr * 64 + 32 + d] = s; }
    float* LAM = (float*)(ws + WS_LAM); bf16_t* BBAR = (bf16_t*)(ws + WS_BBAR); bf16_t* CMAT = (bf16_t*)(ws + WS_CMAT);
    for (int q = gt; q < 2 * 64 * 64 * 16; q += NT) {
        const int c = q & 15, i = q >> 4, p = i & 63, lg = i >> 6;
        const float dt = expf(a.in[10][i]), are = a.in[8][i], aim = a.in[9][i];
        const float mag = expf(are * dt); float sn, cs; sincos_ang(aim * dt, sn, cs);
        const float lbr = mag * cs, lbi = mag * sn;
        if (c == 0) { LAM[2 * i] = lbr; LAM[2 * i + 1] = lbi; }
        const float den = 1.0f / (are * are + aim * aim);
        const float cr = ((lbr - 1.f) * are + lbi * aim) * den, ci = (lbi * are - (lbr - 1.f) * aim) * den;
        const float br = a.in[11][(size_t)i * 16 + c], bi = a.in[12][(size_t)i * 16 + c];
        BBAR[((size_t)(lg * 2 + 0) * 64 + p) * 16 + c] = (bf16_t)f2bf(cr * br - ci * bi);
        BBAR[((size_t)(lg * 2 + 1) * 64 + p) * 16 + c] = (bf16_t)f2bf(cr * bi + ci * br);
        CMAT[((size_t)lg * 16 + c) * 128 + 2 * p] = (bf16_t)f2bf(a.in[13][((size_t)lg * 16 + c) * 64 + p]);
        CMAT[((size_t)lg * 16 + c) * 128 + 2 * p + 1] = (bf16_t)f2bf(-a.in[14][((size_t)lg * 16 + c) * 64 + p]);
    }
}

DEVI f32x4 bf4_to_f32(u32x2 w) { f32x4 r; r[0] = __uint_as_float(w.x << 16); r[1] = __uint_as_float(w.x & 0xffff0000u); r[2] = __uint_as_float(w.y << 16); r[3] = __uint_as_float(w.y & 0xffff0000u); return r; }
#define MFMA32(a, b, c) __builtin_amdgcn_mfma_f32_32x32x16_bf16((a), (b), (c), 0, 0, 0)
#define MFMA16(a, b, c) __builtin_amdgcn_mfma_f32_16x16x32_bf16((a), (b), (c), 0, 0, 0)
template <bool P2>
DEVI void s5_pass(LAS unsigned char* lds, int layer, const bf16_t* x, const float* ss, const float* gain, const float* dsk, const unsigned char* ws_c, unsigned char* ws,
                  float* out_re, float* out_im, int vcu, int G, int tid, int wave, int lane) {
    const float* LAM = (const float*)(ws_c + WS_LAM); const bf16_t* BBAR = (const bf16_t*)(ws_c + WS_BBAR); const bf16_t* CMAT = (const bf16_t*)(ws_c + WS_CMAT);
    float* E = (float*)(ws + WS_E); bf16_t* Gout = (bf16_t*)(ws + WS_G);
    const int r = lane & 31, h = lane >> 5;
    LAS unsigned char* lw = lds + wave * 10752;
    LAS float* rsb = (LAS float*)(lds + 8 * 10752);
    for (int it = vcu; it < 512; it += G) {
        const int gblk = it & 7, pair = (it >> 3) & 15, b = it >> 7;
        const int g = gblk * 8 + wave, lg = layer * 64 + g;
        const int hsel = (r >> 2) & 1, ti = (r & 3) + 4 * (r >> 3);
        const size_t tokA0 = (size_t)b * 4096 + (pair + 16 * hsel) * 128 + ti;
        __syncthreads();
        if (tid < 256) { const int tk = b * 4096 + (pair + 16 * (tid >> 7)) * 128 + (tid & 127); rsb[tid] = rsqrtf(row_ss<4>(ss, tk) * (1.0f / 1024.0f) + EPS); }
        u32x4 xw[8];
#pragma unroll
        for (int iter = 0; iter < 8; ++iter) xw[iter] = *(const u32x4*)(x + (tokA0 + 16 * iter) * 1024 + 16 * g + 8 * h);
        float gn[8];
#pragma unroll
        for (int jx = 0; jx < 8; ++jx) gn[jx] = gain[16 * g + 8 * h + jx];
        bf16x8 bb[2][2];
#pragma unroll
        for (int pt = 0; pt < 2; ++pt)
#pragma unroll
            for (int xx = 0; xx < 2; ++xx) bb[pt][xx] = *(const bf16x8*)(BBAR + ((size_t)(lg * 2 + xx) * 64 + 32 * pt + r) * 16 + 8 * h);
        float lr[2], li[2], sr[2] = {0.f, 0.f}, si[2] = {0.f, 0.f};
#pragma unroll
        for (int pt = 0; pt < 2; ++pt) { lr[pt] = LAM[2 * (lg * 64 + 32 * pt + r)]; li[pt] = LAM[2 * (lg * 64 + 32 * pt + r) + 1]; }
        const int ck = pair + 16 * h;
        bf16x8 cm[4]; float gc = 0.f, dc = 0.f;
        if (P2) {
#pragma unroll
            for (int ks = 0; ks < 4; ++ks) cm[ks] = *(const bf16x8*)(CMAT + ((size_t)lg * 16 + (lane & 15)) * 128 + 32 * ks + 8 * (lane >> 4));
            dc = dsk[16 * g + (lane & 15)];
            float ar[2], ai[2];
#pragma unroll
            for (int pt = 0; pt < 2; ++pt) { ar[pt] = lr[pt]; ai[pt] = li[pt];
#pragma unroll
                for (int q = 0; q < 7; ++q) { const float nr = ar[pt] * ar[pt] - ai[pt] * ai[pt], ni = 2.f * ar[pt] * ai[pt]; ar[pt] = nr; ai[pt] = ni; } }
            float er[31][2], ei[31][2];
#pragma unroll
            for (int jx = 0; jx < 31; ++jx)
#pragma unroll
                for (int pt = 0; pt < 2; ++pt) { const float* e = E + ((size_t)((b * 32 + jx) * 64 + g) * 64 + 32 * pt + r) * 2; er[jx][pt] = e[0]; ei[jx][pt] = e[1]; }
#pragma unroll
            for (int jx = 0; jx < 31; ++jx)
#pragma unroll
                for (int pt = 0; pt < 2; ++pt) {
                    const float nr = ar[pt] * sr[pt] - ai[pt] * si[pt] + er[jx][pt], ni = ar[pt] * si[pt] + ai[pt] * sr[pt] + ei[jx][pt];
                    if (jx < ck) { sr[pt] = nr; si[pt] = ni; }
                }
        }
        __syncthreads();
#pragma unroll
        for (int iter = 0; iter < 8; ++iter) {
            const f32x4 x0 = bf4_to_f32((u32x2){xw[iter].x, xw[iter].y}), x1 = bf4_to_f32((u32x2){xw[iter].z, xw[iter].w});
            const float rs = rsb[128 * hsel + 16 * iter + ti];
            float u[8];
#pragma unroll
            for (int jx = 0; jx < 4; ++jx) { u[jx] = x0[jx] * rs * gn[jx]; u[4 + jx] = x1[jx] * rs * gn[4 + jx]; }
            u32x4 au; au.x = pkbf(u[0], u[1]); au.y = pkbf(u[2], u[3]); au.z = pkbf(u[4], u[5]); au.w = pkbf(u[6], u[7]);
            const bf16x8 af = __builtin_bit_cast(bf16x8, au);
            f32x16 acc[2][2];
#pragma unroll
            for (int pt = 0; pt < 2; ++pt)
#pragma unroll
                for (int xx = 0; xx < 2; ++xx) { f32x16 z = {}; acc[pt][xx] = MFMA32(af, bb[pt][xx], z); }
#pragma unroll
            for (int pt = 0; pt < 2; ++pt)
#pragma unroll
                for (int i = 0; i < 16; ++i) {
                    const float nr = __builtin_fmaf(lr[pt], sr[pt], __builtin_fmaf(-li[pt], si[pt], acc[pt][0][i])), ni = __builtin_fmaf(lr[pt], si[pt], __builtin_fmaf(li[pt], sr[pt], acc[pt][1][i]));
                    sr[pt] = nr; si[pt] = ni; acc[pt][0][i] = nr; acc[pt][1][i] = ni;
                }
            if (P2) {
                asm volatile("" ::: "memory");
                { LAS f32x4* up = (LAS f32x4*)(lw + 8704 + (16 * hsel + ti) * 64 + 32 * h); up[0] = (f32x4){u[0], u[1], u[2], u[3]}; up[1] = (f32x4){u[4], u[5], u[6], u[7]}; }
#pragma unroll
                for (int pt = 0; pt < 2; ++pt)
#pragma unroll
                    for (int i = 0; i < 16; ++i) *(LAS unsigned*)(lw + (16 * h + i) * 272 + 4 * (32 * pt + r)) = pkbf(acc[pt][0][i], acc[pt][1][i]);
                asm volatile("" ::: "memory");
#pragma unroll
                for (int mt = 0; mt < 2; ++mt) {
                    f32x4 y = {0.f, 0.f, 0.f, 0.f};
#pragma unroll
                    for (int ks = 0; ks < 4; ++ks) { const bf16x8 sa = *(const LAS bf16x8*)(lw + (16 * mt + (lane & 15)) * 272 + 64 * ks + 16 * (lane >> 4)); y = MFMA16(sa, cm[ks], y); }
                    const int c = lane & 15;
#pragma unroll
                    for (int q = 0; q < 4; ++q) {
                        const size_t t2 = (size_t)b * 4096 + (pair + 16 * mt) * 128 + 16 * iter + 4 * (lane >> 4) + q;
                        const float uu = *(const LAS float*)(lw + 8704 + (16 * mt + 4 * (lane >> 4) + q) * 64 + 4 * c);
                        const float yy = y[q] + dc * uu;
                        Gout[t2 * 1024 + 16 * g + c] = (bf16_t)(pkbf(gelu_tanh(yy), 0.f) & 0xffffu);
                    }
                }
                asm volatile("" ::: "memory");
            }
        }
        if (!P2) {
#pragma unroll
            for (int pt = 0; pt < 2; ++pt) { float* e = E + ((size_t)((b * 32 + ck) * 64 + g) * 64 + 32 * pt + r) * 2; e[0] = sr[pt]; e[1] = si[pt]; }
        } else if (ck == 31) {
#pragma unroll
            for (int pt = 0; pt < 2; ++pt) { const size_t o = (size_t)((layer * 4 + b) * 64 + g) * 64 + 32 * pt + r; out_re[o] = sr[pt]; out_im[o] = si[pt]; }
        }
        (void)gc;
    }
    __syncthreads();
}

DEVI void s5_sample(int layer, float* xs, float* gs, int gw, int NGW, int lane) {
    const float* const in6 = PIN(6);
    const float* const in15 = PIN(15);
    const float* const in10 = PIN(10);
    const float* const in8 = PIN(8);
    const float* const in9 = PIN(9);
    const float* const in11 = PIN(11);
    const float* const in12 = PIN(12);
    const float* const in2 = PIN(2);
    const float* const in3 = PIN(3);
    const float* const in13 = PIN(13);
    const float* const in14 = PIN(14);
    float* const outp = POUT();
    const float* gain = in6 + layer * 1024; const float* dsk = in15 + layer * 1024;
    const int g = gw & 63, p = lane;
    const int idx = (layer * 64 + g) * 64 + p;
    const float dt = expf(in10[idx]), are = in8[idx], aim = in9[idx];
    const float mag = expf(are * dt); float sn, cs; sincos_ang(aim * dt, sn, cs);
    const float lbr = mag * cs, lbi = mag * sn;
    const float den = 1.0f / (are * are + aim * aim);
    const float cr = ((lbr - 1.f) * are + lbi * aim) * den, ci = (lbi * are - (lbr - 1.f) * aim) * den;
    float bbr[16], bbi[16], ccr[16], cci[16], gg[16];
#pragma unroll
    for (int c4 = 0; c4 < 4; ++c4) { const f32x4 br = *(const f32x4*)(in11 + (size_t)idx * 16 + 4 * c4), bi = *(const f32x4*)(in12 + (size_t)idx * 16 + 4 * c4);
#pragma unroll
        for (int e = 0; e < 4; ++e) { bbr[4 * c4 + e] = cr * br[e] - ci * bi[e]; bbi[4 * c4 + e] = cr * bi[e] + ci * br[e]; } }
#pragma unroll
    for (int c = 0; c < 16; ++c) { const size_t co = ((size_t)(layer * 64 + g) * 16 + c) * 64 + p; ccr[c] = in13[co]; cci[c] = in14[co]; gg[c] = gain[16 * g + c]; }
    const float gl = gain[16 * g + (lane & 15)], dl = dsk[16 * g + (lane & 15)];
    for (int it0 = gw; it0 < NS * 64; it0 += 4 * NGW) {
        f32x4 xv[4][4]; float ux[4][16], s0r[4], s0i[4], ul[4];
#pragma unroll
        for (int k = 0; k < 4; ++k) { const int it = it0 + k * NGW; const int b = (it < NS * 64) ? (it >> 6) : 0;
#pragma unroll
            for (int jx = 0; jx < 4; ++jx) xv[k][jx] = *(const f32x4*)(xs + (size_t)b * 1024 + 4 * lane + 256 * jx);
#pragma unroll
            for (int c = 0; c < 16; ++c) ux[k][c] = xs[(size_t)b * 1024 + 16 * g + c];
            ul[k] = xs[(size_t)b * 1024 + 16 * g + (lane & 15)];
            const size_t sidx = ((size_t)(layer * 128 + b) * 64 + g) * 64 + p; s0r[k] = in2[sidx]; s0i[k] = in3[sidx]; }
#pragma unroll
        for (int k = 0; k < 4; ++k) { const int it = it0 + k * NGW; if (it < NS * 64) {
            const int b = it >> 6;
            float ssq = 0.f;
#pragma unroll
            for (int jx = 0; jx < 4; ++jx) { const f32x4 v = xv[k][jx]; ssq += (v[0] * v[0] + v[1] * v[1]) + (v[2] * v[2] + v[3] * v[3]); }
            const float rs = rsqrtf(wave_sum(ssq) * (1.0f / 1024.0f) + EPS);
            float bur = 0.f, bui = 0.f;
#pragma unroll
            for (int c = 0; c < 16; ++c) { const float u = ux[k][c] * rs * gg[c]; bur += bbr[c] * u; bui += bbi[c] * u; }
            const size_t sidx = ((size_t)(layer * 128 + b) * 64 + g) * 64 + p;
            const float nr = lbr * s0r[k] - lbi * s0i[k] + bur, ni = lbr * s0i[k] + lbi * s0r[k] + bui;
            outp[O_SSRE + sidx] = nr; outp[O_SSIM + sidx] = ni;
            float myy = 0.f;
#pragma unroll
            for (int c = 0; c < 16; ++c) { const float y = wave_sum(ccr[c] * nr - cci[c] * ni); if (lane == c) myy = y; }
            if (lane < 16) gs[(size_t)b * 1024 + 16 * g + lane] = gelu_tanh(myy + dl * (ul[k] * rs * gl));
        } }
    }
}

template <int NT, int CH>
DEVI void sgq_core(const float* A, int lda, int row0, int k0, int nks, const bf16_t* const (&bp)[NT], f32x4 (&acc)[NT], float& ssq, int lane) {
    const float* ap = A + (size_t)(row0 + (lane & 15)) * lda + k0 + 8 * (lane >> 4);
    ssq = 0.f;
#pragma unroll
    for (int nt = 0; nt < NT; ++nt) acc[nt] = (f32x4){0.f, 0.f, 0.f, 0.f};
#pragma unroll 1
    for (int kb = 0; kb < nks; kb += CH) {
        f32x4 a0[CH], a1[CH]; bf16x8 b[CH][NT];
#pragma unroll
        for (int i = 0; i < CH; ++i) { a0[i] = *(const f32x4*)(ap + 32 * (kb + i)); a1[i] = *(const f32x4*)(ap + 32 * (kb + i) + 4);
#pragma unroll
            for (int nt = 0; nt < NT; ++nt) b[i][nt] = *(const bf16x8*)(bp[nt] + 32 * (kb + i)); }
#pragma unroll
        for (int i = 0; i < CH; ++i) {
            ssq += (a0[i][0] * a0[i][0] + a0[i][1] * a0[i][1]) + (a0[i][2] * a0[i][2] + a0[i][3] * a0[i][3]) + (a1[i][0] * a1[i][0] + a1[i][1] * a1[i][1]) + (a1[i][2] * a1[i][2] + a1[i][3] * a1[i][3]);
            u32x4 au; au.x = pkbf(a0[i][0], a0[i][1]); au.y = pkbf(a0[i][2], a0[i][3]); au.z = pkbf(a1[i][0], a1[i][1]); au.w = pkbf(a1[i][2], a1[i][3]);
            const bf16x8 af = __builtin_bit_cast(bf16x8, au);
#pragma unroll
            for (int nt = 0; nt < NT; ++nt) acc[nt] = MFMA16(af, b[i][nt], acc[nt]);
        }
    }
    ssq += __shfl_xor(ssq, 16); ssq += __shfl_xor(ssq, 32);
}
template <int CH>
DEVI void sgq_core_b16(const bf16_t* A, int lda, int row0, int k0, int nks, const bf16_t* bp, f32x4& acc, int lane) {
    const bf16_t* ap = A + (size_t)(row0 + (lane & 15)) * lda + k0 + 8 * (lane >> 4);
    acc = (f32x4){0.f, 0.f, 0.f, 0.f};
#pragma unroll 1
    for (int kb = 0; kb < nks; kb += CH) {
        bf16x8 a[CH], b[CH];
#pragma unroll
        for (int i = 0; i < CH; ++i) { a[i] = *(const bf16x8*)(ap + 32 * (kb + i)); b[i] = *(const bf16x8*)(bp + 32 * (kb + i)); }
#pragma unroll
        for (int i = 0; i < CH; ++i) acc = MFMA16(a[i], b[i], acc);
    }
}
template <int NT> DEVI bool sgq_reduce(LAS unsigned char* lds, f32x4 (&acc)[NT], float& ssq, int wave, int lane) {
    LAS f32x4* red = (LAS f32x4*)lds;
    LAS float* rss = (LAS float*)(lds + 32768);
    __syncthreads();
#pragma unroll
    for (int nt = 0; nt < NT; ++nt) red[(wave * NT + nt) * 64 + lane] = acc[nt];
    rss[wave * 64 + lane] = ssq;
    __syncthreads();
    const int rt = wave & 1;
    if ((wave >> 1) != 0) return false;
#pragma unroll
    for (int nt = 0; nt < NT; ++nt) acc[nt] = (red[(rt * NT + nt) * 64 + lane] + red[((2 + rt) * NT + nt) * 64 + lane]) + (red[((4 + rt) * NT + nt) * 64 + lane] + red[((6 + rt) * NT + nt) * 64 + lane]);
    ssq = (rss[rt * 64 + lane] + rss[(2 + rt) * 64 + lane]) + (rss[(4 + rt) * 64 + lane] + rss[(6 + rt) * 64 + lane]);
    return true;
}
DEVI void row_rstd(float ssq, float (&rs)[4], int lane) {
    const float r = rsqrtf(ssq * (1.0f / 1024.0f) + EPS);
#pragma unroll
    for (int q = 0; q < 4; ++q) rs[q] = __shfl(r, 4 * (lane >> 4) + q);
}
DEVI void sample_glu(int layer, LAS unsigned char* lds, const float* gs, float* xs, int vcu, int G, int wave, int lane) {
    const float* const in17 = PIN(17);
    unsigned char* const wsp = PWS();
    const bf16_t* Wt = (const bf16_t*)(wsp + WS_WGLU) + (size_t)layer * 2048 * 1024; const float* bias = in17 + layer * 2048;
    for (int it = vcu; it < 256; it += G) {
        const int s = it >> 2, rq = it & 3, n = lane & 15, rt = wave & 1, kq = wave >> 1, row0 = 32 * rq + 16 * rt, rv = 256 * (s >> 3) + 16 * (s & 7) + n;
        const bf16_t* bp[2] = {Wt + (size_t)rv * 1024 + 256 * kq + 8 * (lane >> 4), Wt + (size_t)(rv + 128) * 1024 + 256 * kq + 8 * (lane >> 4)};
        f32x4 acc[2]; float ssq; sgq_core<2, 8>(gs, 1024, row0, 256 * kq, 8, bp, acc, ssq, lane);
        if (sgq_reduce<2>(lds, acc, ssq, wave, lane)) {
            const int col = 16 * s + n; const float bv = bias[col], bg = bias[1024 + col];
#pragma unroll
            for (int q = 0; q < 4; ++q) { const int row = row0 + 4 * (lane >> 4) + q; xs[(size_t)row * 1024 + col] += (acc[0][q] + bv) * sigmoidf_(acc[1][q] + bg); }
        }
    }
}
DEVI void sample_mlpin(int layer, LAS unsigned char* lds, const float* xs, bf16_t* hs, int vcu, int G, int wave, int lane) {
    unsigned char* const wsp = PWS();
    const bf16_t* Wt = (const bf16_t*)(wsp + WS_WIN) + (size_t)layer * 4096 * 1024;
    for (int it = vcu; it < 256; it += G) {
        const int cgp = it >> 2, rq = it & 3, n = lane & 15, rt = wave & 1, kq = wave >> 1, row0 = 32 * rq + 16 * rt;
        const bf16_t* bp[4];
#pragma unroll
        for (int nt = 0; nt < 4; ++nt) bp[nt] = Wt + (size_t)(64 * cgp + 16 * nt + n) * 1024 + 256 * kq + 8 * (lane >> 4);
        f32x4 acc[4]; float ssq; sgq_core<4, 8>(xs, 1024, row0, 256 * kq, 8, bp, acc, ssq, lane);
        if (sgq_reduce<4>(lds, acc, ssq, wave, lane)) {
            float rs[4]; row_rstd(ssq, rs, lane);
#pragma unroll
            for (int q = 0; q < 4; ++q) { const int row = row0 + 4 * (lane >> 4) + q;
#pragma unroll
                for (int nt = 0; nt < 4; ++nt) { const float v = fmaxf(acc[nt][q] * rs[q], 0.f); hs[(size_t)row * 4096 + 64 * cgp + 16 * nt + n] = (bf16_t)(pkbf(v * v, 0.f) & 0xffffu); } }
        }
    }
}
DEVI void sample_mlpout(int layer, LAS unsigned char* lds, const bf16_t* hs, float* xs, int vcu, int G, int wave, int lane) {
    unsigned char* const wsp = PWS();
    const bf16_t* Wt = (const bf16_t*)(wsp + WS_WOUT) + (size_t)layer * 1024 * 4096;
    for (int it = vcu; it < 256; it += G) {
        const int s = it >> 2, rq = it & 3, n = lane & 15, rt = wave & 1, kq = wave >> 1, row0 = 32 * rq + 16 * rt;
        const bf16_t* bp[1] = {Wt + (size_t)(16 * s + n) * 4096 + 1024 * kq + 8 * (lane >> 4)};
        f32x4 acc[1]; float ssq = 0.f; sgq_core_b16<32>(hs, 4096, row0, 1024 * kq, 32, bp[0], acc[0], lane);
        if (sgq_reduce<1>(lds, acc, ssq, wave, lane)) {
#pragma unroll
            for (int q = 0; q < 4; ++q) { const int row = row0 + 4 * (lane >> 4) + q; xs[(size_t)row * 1024 + 16 * s + n] += acc[0][q]; }
        }
    }
}
DEVI void sample_oproj(int j, LAS unsigned char* lds, const float* os, float* xs, int vcu, int G, int wave, int lane) {
    unsigned char* const wsp = PWS();
    const bf16_t* Wt = (const bf16_t*)(wsp + WS_WO) + (size_t)j * 1024 * 1024;
    for (int it = vcu; it < 256; it += G) {
        const int s = it >> 2, rq = it & 3, n = lane & 15, rt = wave & 1, kq = wave >> 1, row0 = 32 * rq + 16 * rt;
        const bf16_t* bp[1] = {Wt + (size_t)(16 * s + n) * 1024 + 256 * kq + 8 * (lane >> 4)};
        f32x4 acc[1]; float ssq; sgq_core<1, 8>(os, 1024, row0, 256 * kq, 8, bp, acc, ssq, lane);
        if (sgq_reduce<1>(lds, acc, ssq, wave, lane)) {
#pragma unroll
            for (int q = 0; q < 4; ++q) { const int row = row0 + 4 * (lane >> 4) + q; xs[(size_t)row * 1024 + 16 * s + n] += acc[0][q]; }
        }
    }
}
DEVI void sample_qkv(int j, LAS unsigned char* lds, const float* xs, float* qs, int vcu, int G, int wave, int lane) {
    const float* const in23 = PIN(23);
    const float* const in21 = PIN(21);
    float* const outp = POUT();
    unsigned char* const wsp = PWS();
    const bf16_t* Wt = (const bf16_t*)(wsp + (j == 0 ? WS_WQKV : WS_WQ1));
    const float* rope = (const float*)(wsp + WS_ROPE) + (size_t)4096 * 64;
    const int nitems = (j == 0) ? 96 : 64;
    const bool idle_half = (j == 0) && (G == 256);
    if (idle_half && (vcu & 31) < 16) return;
    const int first = idle_half ? ((vcu >> 5) * 16 + (vcu & 31) - 16) : vcu, stride = idle_half ? 128 : G;
    for (int it0 = first; it0 < nitems; it0 += stride) {
        const int it = it0 >> 2, rq = it0 & 3, rt = wave & 1, kq = wave >> 1, row0 = 32 * rq + 16 * rt;
        const int n = lane & 15; int rows[4]; int kind, hd;
        if (it < 16) { kind = 0; hd = it;
#pragma unroll
            for (int nt = 0; nt < 4; ++nt) rows[nt] = 256 * (hd >> 2) + 128 * (nt >> 1) + 32 * (hd & 3) + 16 * (nt & 1) + n; }
        else if (it < 20) { kind = 1; hd = it - 16;
#pragma unroll
            for (int nt = 0; nt < 4; ++nt) rows[nt] = 1024 + 128 * (nt >> 1) + 32 * hd + 16 * (nt & 1) + n; }
        else { kind = 2; hd = it - 20;
#pragma unroll
            for (int nt = 0; nt < 4; ++nt) rows[nt] = 1280 + 64 * hd + 16 * nt + n; }
        const bf16_t* bp[4];
#pragma unroll
        for (int nt = 0; nt < 4; ++nt) bp[nt] = Wt + (size_t)rows[nt] * 1024 + 256 * kq + 8 * (lane >> 4);
        f32x4 acc[4]; float ssq; sgq_core<4, 8>(xs, 1024, row0, 256 * kq, 8, bp, acc, ssq, lane);
        if (sgq_reduce<4>(lds, acc, ssq, wave, lane)) {
            float rs[4]; row_rstd(ssq, rs, lane);
#pragma unroll
            for (int q = 0; q < 4; ++q) {
                const int row = row0 + 4 * (lane >> 4) + q;
                float v[4];
#pragma unroll
                for (int nt = 0; nt < 4; ++nt) v[nt] = acc[nt][q] * rs[q];
                if (kind == 2) {
#pragma unroll
                    for (int nt = 0; nt < 4; ++nt) outp[O_VS + ((size_t)(row * 128 + 127) * 4 + hd) * 64 + 16 * nt + n] = v[nt];
                } else {
                    float sq = (v[0] * v[0] + v[1] * v[1]) + (v[2] * v[2] + v[3] * v[3]);
                    sq += __shfl_xor(sq, 1); sq += __shfl_xor(sq, 2); sq += __shfl_xor(sq, 4); sq += __shfl_xor(sq, 8);
                    const float rn = rsqrtf(sq * (1.0f / 64.0f) + EPS);
                    const float* gn = (kind == 0) ? (in23 + j * 64) : in21;
                    float o[4];
#pragma unroll
                    for (int t = 0; t < 2; ++t) { const int d = 16 * t + n; const float cs = rope[d], sn = rope[32 + d];
                        const float x1 = v[t] * rn * gn[d], x2 = v[t + 2] * rn * gn[32 + d];
                        o[t] = x1 * cs - x2 * sn; o[t + 2] = x2 * cs + x1 * sn; }
                    float* dst = (kind == 0) ? (qs + (size_t)row * 1024 + hd * 64) : (outp + O_KS + ((size_t)(row * 128 + 127) * 4 + hd) * 64);
#pragma unroll
                    for (int nt = 0; nt < 4; ++nt) dst[16 * nt + n] = o[nt];
                }
            }
        }
    }
}
DEVI void sample_attn(int j, LAS unsigned char* lds, const float* qs, float* os, int vcu, int G, int wave, int lane) {
    const float* const in24 = PIN(24);
    const float* const in4 = PIN(4);
    const float* const in5 = PIN(5);
    float* const outp = POUT();
    LAS float* L = (LAS float*)lds;
    for (int wi = vcu; wi < 256; wi += G) {
        const int itm = wave >> 2, q = wave & 3, it = 2 * wi + itm, b = it >> 2, kvh = it & 3;
        const float* sinks = in24 + j * 16 + kvh * 4;
        __syncthreads();
        L[itm * 256 + q * 64 + lane] = qs[(size_t)b * 1024 + (kvh * 4 + q) * 64 + lane];
        const int rr = lane & 31, hf = lane >> 5, row = 32 * q + rr;
        const float* kp = in4 + ((size_t)(b * 128 + row) * 4 + kvh) * 64 + 32 * hf;
        f32x4 kv[8];
#pragma unroll
        for (int i = 0; i < 8; ++i) kv[i] = *(const f32x4*)(kp + 4 * i);
        float vv[32]; const float* vp = in5 + ((size_t)(b * 128 + 32 * q) * 4 + kvh) * 64 + lane;
#pragma unroll
        for (int i = 0; i < 32; ++i) vv[i] = vp[(size_t)i * 256];
        const float kn = outp[O_KS + ((size_t)(b * 128 + 127) * 4 + kvh) * 64 + lane], vn = outp[O_VS + ((size_t)(b * 128 + 127) * 4 + kvh) * 64 + lane];
        __syncthreads();
        float a[4], an[4];
#pragma unroll
        for (int hh = 0; hh < 4; ++hh) {
            float sd = 0.f;
#pragma unroll
            for (int i = 0; i < 8; ++i) { const f32x4 qq = *(const LAS f32x4*)(L + itm * 256 + hh * 64 + 32 * hf + 4 * i); sd += (kv[i][0] * qq[0] + kv[i][1] * qq[1]) + (kv[i][2] * qq[2] + kv[i][3] * qq[3]); }
            sd += __shfl_xor(sd, 32);
            a[hh] = (row >= 1) ? sd * 0.125f : -INFINITY;
            an[hh] = wave_sum(kn * L[itm * 256 + hh * 64 + lane]) * 0.125f;
            const float mw = wave_max(a[hh]);
            if (lane == 0) L[512 + ((itm * 4 + q) * 4 + hh) * 2] = mw;
        }
        __syncthreads();
        float m[4];
#pragma unroll
        for (int hh = 0; hh < 4; ++hh) {
            float mm = fmaxf(an[hh], sinks[hh]);
#pragma unroll
            for (int w = 0; w < 4; ++w) mm = fmaxf(mm, L[512 + ((itm * 4 + w) * 4 + hh) * 2]);
            m[hh] = mm;
            const float p = __expf(a[hh] - mm);
            const float sw = wave_sum(p) * 0.5f;
            if (lane == 0) L[512 + ((itm * 4 + q) * 4 + hh) * 2 + 1] = sw;
            if (lane < 32) L[640 + (itm * 4 + hh) * 132 + row] = p;
        }
        __syncthreads();
#pragma unroll
        for (int hh = 0; hh < 4; ++hh) {
            float o = 0.f;
#pragma unroll
            for (int i = 0; i < 32; ++i) o += L[640 + (itm * 4 + hh) * 132 + 32 * q + i] * vv[i];
            if (q == 3) o += __expf(an[hh] - m[hh]) * vn;
            L[1792 + ((itm * 4 + q) * 4 + hh) * 64 + lane] = o;
        }
        __syncthreads();
#pragma unroll
        for (int hh = 0; hh < 4; ++hh) if (hh == q) {
            float tot = __expf(an[hh] - m[hh]) + __expf(sinks[hh] - m[hh]);
            tot += (L[512 + ((itm * 4 + 0) * 4 + hh) * 2 + 1] + L[512 + ((itm * 4 + 1) * 4 + hh) * 2 + 1]) + (L[512 + ((itm * 4 + 2) * 4 + hh) * 2 + 1] + L[512 + ((itm * 4 + 3) * 4 + hh) * 2 + 1]);
            const float val = (L[1792 + ((itm * 4 + 0) * 4 + hh) * 64 + lane] + L[1792 + ((itm * 4 + 1) * 4 + hh) * 64 + lane]) + (L[1792 + ((itm * 4 + 2) * 4 + hh) * 64 + lane] + L[1792 + ((itm * 4 + 3) * 4 + hh) * 64 + lane]);
            os[(size_t)b * 1024 + (kvh * 4 + hh) * 64 + lane] = val / tot;
        }
    }
    __syncthreads();
}

DEVI void attn_prompt(LAS unsigned char* lds, const bf16_t* Q, const bf16_t* Kb, const bf16_t* Vb, bf16_t* O, const float* sinks, int vcu, int G, int tid, int wave, int lane) {
    constexpr int KP = 144, VP = 528, VOFF = 256 * KP;
    const int ql = lane & 31, h = lane >> 5;
    for (int it = vcu; it < 512; it += G) {
        const int kvh = it & 3, qb = (it >> 2) & 31, b = it >> 7;
        __syncthreads();
        const int hq = kvh * 4 + (wave >> 1);
        bf16x8 qfa[2][4];
#pragma unroll
        for (int j = 0; j < 2; ++j)
#pragma unroll
            for (int s = 0; s < 4; ++s) qfa[j][s] = *(const bf16x8*)(Q + ((size_t)b * 4096 + qb * 128 + 32 * (2 * (wave & 1) + j) + ql) * 1024 + hq * 64 + 16 * s + 8 * h);
        const long tok0 = (long)b * 4096 + (long)(qb - 1) * 128;
#pragma unroll
        for (int i = 0; i < 4; ++i) {
            const int kk = (tid >> 3) + 64 * i, ch = tid & 7; const bool ok = (qb > 0) || (kk >= 128);
            u32x4 kv = {0u, 0u, 0u, 0u}, vv = {0u, 0u, 0u, 0u};
            if (ok) { kv = *(const u32x4*)(Kb + (size_t)(tok0 + kk) * 256 + kvh * 64 + 8 * ch); vv = *(const u32x4*)(Vb + (size_t)(tok0 + kk) * 256 + kvh * 64 + 8 * ch); }
            *(LAS u32x4*)(lds + kk * KP + 16 * ch) = kv;
            const int o = kk & 15, pos = (kk & ~15) + 8 * ((o >> 2) & 1) + 4 * (o >> 3) + (o & 3);
#pragma unroll
            for (int jx = 0; jx < 8; ++jx) *(LAS unsigned short*)(lds + VOFF + (8 * ch + jx) * VP + 2 * pos) = (unsigned short)(vv[jx >> 1] >> (16 * (jx & 1)));
        }
        __syncthreads();
        const float sink2 = sinks[hq] * LOG2E;
#pragma unroll
        for (int j = 0; j < 2; ++j) {
            const int jj = 2 * (wave & 1) + j;
            const size_t qtok = (size_t)b * 4096 + qb * 128 + 32 * jj + ql;
            const bf16x8 (&qf)[4] = qfa[j];
            f32x16 sc[5];
#pragma unroll
            for (int tt = 0; tt < 5; ++tt) {
                f32x16 acc = {};
#pragma unroll
                for (int s = 0; s < 4; ++s) { const bf16x8 ka = *(const LAS bf16x8*)(lds + (32 * (jj + tt) + ql) * KP + (16 * s + 8 * h) * 2); acc = MFMA32(ka, qf[s], acc); }
                sc[tt] = acc;
            }
            float mx = sink2;
#pragma unroll
            for (int tt = 0; tt < 5; ++tt)
#pragma unroll
                for (int i = 0; i < 16; ++i) {
                    const int krow = (i & 3) + 8 * (i >> 2) + 4 * h, kk = 32 * (jj + tt) + krow;
                    bool valid = (tt == 0) ? (krow > ql) : ((tt == 4) ? (krow <= ql) : true);
                    if (qb == 0 && kk < 128) valid = false;
                    const float v = valid ? sc[tt][i] : -INFINITY; sc[tt][i] = v; mx = fmaxf(mx, v);
                }
            mx = fmaxf(mx, __shfl_xor(mx, 32));
            float sum = 0.f;
#pragma unroll
            for (int tt = 0; tt < 5; ++tt)
#pragma unroll
                for (int i = 0; i < 16; ++i) { const float p = __builtin_amdgcn_exp2f(sc[tt][i] - mx); sc[tt][i] = p; sum += p; }
            sum += __shfl_xor(sum, 32);
            const float inv = 1.0f / (sum + __builtin_amdgcn_exp2f(sink2 - mx));
            f32x16 o[2] = {{}, {}};
#pragma unroll
            for (int tt = 0; tt < 5; ++tt)
#pragma unroll
                for (int s2 = 0; s2 < 2; ++s2) {
                    u32x4 pu; pu.x = pkbf(sc[tt][8 * s2 + 0], sc[tt][8 * s2 + 1]); pu.y = pkbf(sc[tt][8 * s2 + 2], sc[tt][8 * s2 + 3]);
                    pu.z = pkbf(sc[tt][8 * s2 + 4], sc[tt][8 * s2 + 5]); pu.w = pkbf(sc[tt][8 * s2 + 6], sc[tt][8 * s2 + 7]);
                    const bf16x8 pb = __builtin_bit_cast(bf16x8, pu);
#pragma unroll
                    for (int dt = 0; dt < 2; ++dt) { const bf16x8 va = *(const LAS bf16x8*)(lds + VOFF + (32 * dt + ql) * VP + (32 * (jj + tt) + 16 * s2 + 8 * h) * 2); o[dt] = MFMA32(va, pb, o[dt]); }
                }
#pragma unroll
            for (int dt = 0; dt < 2; ++dt)
#pragma unroll
                for (int i4 = 0; i4 < 4; ++i4) {
                    u32x2 w; w.x = pkbf(o[dt][4 * i4] * inv, o[dt][4 * i4 + 1] * inv); w.y = pkbf(o[dt][4 * i4 + 2] * inv, o[dt][4 * i4 + 3] * inv);
                    *(u32x2*)(O + qtok * 1024 + hq * 64 + 32 * dt + 8 * i4 + 4 * h) = w;
                }
        }
    }
    __syncthreads();
}

#define XB_TMO      128
#define XB_XCNT(j)  (256  + 64 * (j))
#define XB_XSUB(j)  (1280 + 64 * (j))
#define XB_XGEN(j)  (2304 + 64 * (j))
#define XB_TOP      3328
#define XB_TOPGEN   3392
#define XCD_BAR_WORDS 3456
#define XB_SPIN_CAP (1u << 18)

__device__ __forceinline__ unsigned xb_ld(unsigned* p)              { return __hip_atomic_load(p, __ATOMIC_RELAXED, __HIP_MEMORY_SCOPE_AGENT); }
__device__ __forceinline__ unsigned xb_add(unsigned* p, unsigned v) { return __hip_atomic_fetch_add(p, v, __ATOMIC_RELAXED, __HIP_MEMORY_SCOPE_AGENT); }
__device__ __forceinline__ unsigned xb_xcc_id() { return (unsigned)__builtin_amdgcn_s_getreg((3 << 11) | 20) & 0xFu; }
#define XB_SPIN(cond, bar) do { unsigned _sp = 0; while (cond) { __builtin_amdgcn_s_sleep(1); \
    if ((++_sp & 255u) == 0u) { if (xb_ld(&(bar)[XB_TMO])) break; if (_sp > XB_SPIN_CAP) { atomicAdd(&(bar)[XB_TMO], 1u); break; } } } } while (0)

struct XcdBarrier {
    unsigned* bar; unsigned x;
    volatile LAS unsigned* st;
};

__device__ __forceinline__ XcdBarrier xcd_barrier_post(unsigned* bar, volatile LAS unsigned* st) {
    XcdBarrier b; b.bar = bar; b.x = xb_xcc_id(); b.st = st;
    if (threadIdx.x == 0) (void)xb_add(&bar[XB_XCNT(b.x)], 1u);
    return b;
}
__device__ __forceinline__ void xcd_barrier_complete(unsigned* bar, unsigned x, unsigned& nloc, unsigned& nx) {
    const unsigned G = gridDim.x * gridDim.y * gridDim.z;
    unsigned sum, cnt, mine, sp = 0u;
    for (;;) {
        sum = 0u; cnt = 0u; mine = 0u;
#pragma unroll
        for (unsigned j = 0; j < 16; ++j) { const unsigned c = xb_ld(&bar[XB_XCNT(j)]); sum += c; cnt += (c > 0u) ? 1u : 0u; mine = (j == x) ? c : mine; }
        if (sum == G) break;
        __builtin_amdgcn_s_sleep(1);
        if ((++sp & 255u) == 0u) { if (xb_ld(&bar[XB_TMO])) break; if (sp > XB_SPIN_CAP) { atomicAdd(&bar[XB_TMO], 1u); break; } }
    }
    nloc = mine > 0u ? mine : 1u; nx = cnt > 0u ? cnt : 1u;
}

__device__ __forceinline__ void xcd_barrier(const XcdBarrier& b) {
    asm volatile("s_waitcnt vmcnt(0)" ::: "memory");
    __syncthreads();
    if (threadIdx.x == 0) {
        unsigned* bar = b.bar;
        __builtin_amdgcn_s_waitcnt(0);
        asm volatile("buffer_inv sc1" ::: "memory");
        unsigned nloc = b.st[0], nx = b.st[1];
        if (nloc == 0u) { xcd_barrier_complete(bar, b.x, nloc, nx); b.st[0] = nloc; b.st[1] = nx; }
        const unsigned old = xb_add(&bar[XB_XSUB(b.x)], 1u);
        const unsigned gen = old / nloc;
        if (nloc >= 8u && old - gen * nloc == nloc - 4u) asm volatile("buffer_wbl2 sc1" ::: "memory");
        if (old + 1u == (gen + 1u) * nloc) {
            __builtin_amdgcn_fence(__ATOMIC_RELEASE, "agent");
            asm volatile("s_waitcnt vmcnt(0)" ::: "memory");
            const unsigned og = xb_add(&bar[XB_TOP], 1u);
            const unsigned tg = og / nx;
            if (og + 1u == (tg + 1u) * nx) xb_add(&bar[XB_TOPGEN], 1u);
            else XB_SPIN(xb_ld(&bar[XB_TOPGEN]) == tg, bar);
            asm volatile("" ::: "memory");
            xb_add(&bar[XB_XGEN(b.x)], 1u);
            asm volatile("s_waitcnt vmcnt(0)" ::: "memory");
        } else {
            XB_SPIN(xb_ld(&bar[XB_XGEN(b.x)]) == gen, bar);
            asm volatile("" ::: "memory");
            asm volatile("s_waitcnt vmcnt(0)" ::: "memory");
        }
    }
    __syncthreads();
}

constexpr int NPHASE = 21;
#ifndef NPH_RUN
#define NPH_RUN NPHASE
#endif
#ifndef KMASK
#define KMASK 0xffff
#endif
#define KON(b) ((KMASK >> (b)) & 1)
#ifndef REPMASK
#define REPMASK 0
#endif
#ifndef BARX2
#define BARX2 0
#endif
#define NREP(b) ((((REPMASK) >> (b)) & 1) ? 2 : 1)
DEVI int opaque_tid() { int t; asm volatile("v_mov_b32 %0, %1" : "=v"(t) : "v"((int)threadIdx.x)); return t; }
DEVI int opaque_bid() { int b; asm volatile("s_mov_b32 %0, %1" : "=s"(b) : "s"((int)blockIdx.x)); return b; }
#define GEO() const int tid = opaque_tid(), lane = tid & 63, wave = __builtin_amdgcn_readfirstlane(tid >> 6); \
    const int G = gridDim.x, bx = opaque_bid(), vcu = (G % 8 == 0) ? (bx % 8) * (G / 8) + bx / 8 : bx; \
    const int gw = vcu * NWAVES + wave, NGW = G * NWAVES; (void)gw; (void)NGW; (void)lane; (void)tid; (void)vcu
__global__ void __launch_bounds__(NWAVES * 64, 2) yoco_fwd(Args args) {
    extern __shared__ __attribute__((aligned(16))) unsigned char lds_raw[];
    LAS unsigned char* lds = (LAS unsigned char*)lds_raw;
    if (threadIdx.x == 0) {
        LAS unsigned long long* PT = (LAS unsigned long long*)(lds + PT_OFF);
#pragma unroll
        for (int k = 0; k < 28; ++k) PT[k] = (unsigned long long)args.in[k];
        PT[28] = (unsigned long long)args.out; PT[29] = (unsigned long long)args.ws;
        ((LAS unsigned*)(lds + PT_OFF + 512))[0] = 0u; ((LAS unsigned*)(lds + PT_OFF + 512))[1] = 0u;
    }
    __syncthreads();
    const int lo = args.ph_lo, hi = args.ph_hi;
#if MULTI
#define SEAM(k) do {} while (0)
#else
    cg::grid_group grid = cg::this_grid();
    (void)xcd_barrier_post((unsigned*)args.ws, (volatile LAS unsigned*)(lds + PT_OFF + 512));
#define SEAM(k) do { if (lo <= (k) && (k) + 1 < hi) { if (hi < 0) grid.sync(); else { XcdBarrier xb_; xb_.bar = (unsigned*)PWS(); xb_.x = xb_xcc_id(); xb_.st = (volatile LAS unsigned*)(lds + PT_OFF + 512); xcd_barrier(xb_); if (BARX2) xcd_barrier(xb_); } } } while (0)
#endif
#define IN(k) (lo <= (k) && (k) < hi)

    if (KON(0) && IN(0)) for (int rp_ = 0; rp_ < NREP(0); ++rp_) { GEO(); prologue(args, lds, vcu, G, tid, wave, lane); }
    SEAM(0);
#pragma unroll 1
    for (int L = 0; L < 2; ++L) {
        const int pb = 1 + 5 * L;
        if (KON(1) && IN(pb)) for (int rp_ = 0; rp_ < NREP(1); ++rp_) { GEO(); unsigned char* ws = PWS(); const bf16_t* xin = (const bf16_t*)(ws + WS_XB);
            s5_pass<false>(lds, L, xin, (const float*)(ws + WS_PS), PIN(6) + L * 1024, PIN(15) + L * 1024, ws, ws, nullptr, nullptr, vcu, G, tid, wave, lane); }
        SEAM(pb);
        if (IN(pb + 1)) {
            if (KON(2)) for (int rp_ = 0; rp_ < NREP(2); ++rp_) { GEO(); unsigned char* ws = PWS(); float* out = POUT(); const bf16_t* xin = (const bf16_t*)(ws + WS_XB);
                s5_pass<true>(lds, L, xin, (const float*)(ws + WS_PS), PIN(6) + L * 1024, PIN(15) + L * 1024, ws, ws, out + O_SPRE, out + O_SPIM, vcu, G, tid, wave, lane); }
            if (KON(9)) for (int rp_ = 0; rp_ < NREP(10); ++rp_) { GEO(); unsigned char* ws = PWS(); float* out = POUT(); s5_sample(L, out + O_YS, (float*)(ws + WS_GS), gw, NGW, lane); }
        }
        SEAM(pb + 1);
        if (IN(pb + 2)) {
            if (KON(3)) { const int G = gridDim.x, bx = opaque_bid(); unsigned char* ws = PWS(); float* PS = (float*)(ws + WS_PS);
                pg8::Gemm g{(const bf16_t*)(ws + WS_G), (const bf16_t*)(ws + WS_WGLU) + (size_t)L * 2048 * 1024, MP, 2048, 1024}; pg8::StaticOrder S; S.init(MP, 2048, G, bx);
                pg8::EpiGlu E{(bf16_t*)(ws + WS_XB), PS, PIN(17) + L * 2048};
                pg8::gemm_phase<pg8::EpiGlu, pg8::StaticOrder, true, true>(lds, g, S, E); }
            if (KON(9)) { GEO(); unsigned char* ws = PWS(); float* out = POUT(); sample_glu(L, lds, (const float*)(ws + WS_GS), out + O_YS, vcu, G, wave, lane); }
        }
        SEAM(pb + 2);
        if (IN(pb + 3)) {
            if (KON(4)) for (int rp_ = 0; rp_ < NREP(4); ++rp_) { const int G = gridDim.x, bx = opaque_bid(); unsigned char* ws = PWS(); float* PS = (float*)(ws + WS_PS);
                pg8::Gemm g{(const bf16_t*)(ws + WS_XB), (const bf16_t*)(ws + WS_WIN) + (size_t)L * 4096 * 1024, MP, 4096, 1024}; pg8::StaticOrder S; S.init(MP, 4096, G, bx);
                pg8::EpiMlpIn<8> E{(bf16_t*)(ws + WS_H), PS, __builtin_amdgcn_make_buffer_rsrc((void*)ws, (short)0, (int)WS_END, 0x00020000)};
                pg8::gemm_phase<pg8::EpiMlpIn<8>, pg8::StaticOrder, true, true>(lds, g, S, E); }
            if (KON(9)) for (int rp_ = 0; rp_ < NREP(10); ++rp_) { GEO(); unsigned char* ws = PWS(); float* out = POUT(); sample_mlpin(L, lds, out + O_YS, (bf16_t*)(ws + WS_HS), vcu, G, wave, lane); }
        }
        SEAM(pb + 3);
        if (IN(pb + 4)) {
            if (KON(5)) { const int G = gridDim.x, bx = opaque_bid(); unsigned char* ws = PWS(); float* out = POUT(); float* PS = (float*)(ws + WS_PS);
                pg8::Gemm g{(const bf16_t*)(ws + WS_H), (const bf16_t*)(ws + WS_WOUT) + (size_t)L * 1024 * 4096, MP, 1024, 4096}; pg8::StaticOrder S; S.init(MP, 1024, G, bx);
                pg8::EpiResid E{(bf16_t*)(ws + WS_XB), nullptr, PS};
                pg8::gemm_phase<pg8::EpiResid, pg8::StaticOrder, false, true>(lds, g, S, E); }
            if (KON(9)) { GEO(); unsigned char* ws = PWS(); float* out = POUT(); sample_mlpout(L, lds, (const bf16_t*)(ws + WS_HS), out + O_YS, vcu, G, wave, lane); }
        }
        SEAM(pb + 4);
    }
#pragma unroll 1
    for (int j = 0; j < 2; ++j) {
        const int pb = 11 + 5 * j, L = 2 + j;
        if (IN(pb)) {
            if (KON(6)) for (int rp_ = 0; rp_ < NREP(6); ++rp_) { const int G = gridDim.x, bx = opaque_bid(); unsigned char* ws = PWS(); float* out = POUT(); float* PS = (float*)(ws + WS_PS);
                const int N = (j == 0) ? 1536 : 1024;
                pg8::Gemm g{(const bf16_t*)(ws + WS_XB), (const bf16_t*)(ws + (j == 0 ? WS_WQKV : WS_WQ1)), MP, N, 1024}; pg8::StaticOrder S; S.init(MP, N, G, bx);
                pg8::EpiQKV E{(bf16_t*)(ws + WS_Q), (bf16_t*)(ws + WS_K), (bf16_t*)(ws + WS_V), PS, PIN(23) + j * 64, PIN(21), (const float*)(ws + WS_ROPE), out + O_KP, out + O_VP, 4};
                pg8::gemm_phase<pg8::EpiQKV, pg8::StaticOrder, true, true>(lds, g, S, E); }
            if (KON(9)) for (int rp_ = 0; rp_ < NREP(10); ++rp_) { GEO(); unsigned char* ws = PWS(); float* out = POUT(); sample_qkv(j, lds, out + O_YS, (float*)(ws + WS_QS), vcu, G, wave, lane);
                if (MULTI == 0 && j == 0 && G == 256 && (vcu & 31) >= 16) cache_copy(PIN(4), PIN(5), out, ((vcu >> 5) * 16 + (vcu & 31) - 16) * 512 + tid, 128 * 512); }
        }
        SEAM(pb);
        if (IN(pb + 1)) {
            if (KON(7)) for (int rp_ = 0; rp_ < NREP(7); ++rp_) { GEO(); unsigned char* ws = PWS(); attn_prompt(lds, (const bf16_t*)(ws + WS_Q), (const bf16_t*)(ws + WS_K), (const bf16_t*)(ws + WS_V), (bf16_t*)(ws + WS_O), PIN(24) + j * 16, vcu, G, tid, wave, lane); }
            if (KON(9)) for (int rp_ = 0; rp_ < NREP(10); ++rp_) { GEO(); unsigned char* ws = PWS(); sample_attn(j, lds, (const float*)(ws + WS_QS), (float*)(ws + WS_OS), vcu, G, wave, lane); }
        }
        SEAM(pb + 1);
        if (IN(pb + 2)) {
            if (KON(5)) { const int G = gridDim.x, bx = opaque_bid(); unsigned char* ws = PWS(); float* out = POUT(); float* PS = (float*)(ws + WS_PS);
                pg8::Gemm g{(const bf16_t*)(ws + WS_O), (const bf16_t*)(ws + WS_WO) + (size_t)j * 1024 * 1024, MP, 1024, 1024}; pg8::StaticOrder S; S.init(MP, 1024, G, bx);
                pg8::EpiResid E{(bf16_t*)(ws + WS_XB), nullptr, PS};
                pg8::gemm_phase<pg8::EpiResid, pg8::StaticOrder, false, true>(lds, g, S, E); }
            if (KON(9)) { GEO(); unsigned char* ws = PWS(); float* out = POUT(); sample_oproj(j, lds, (const float*)(ws + WS_OS), out + O_YS, vcu, G, wave, lane); }
        }
        SEAM(pb + 2);
        if (IN(pb + 3)) {
            if (KON(4)) for (int rp_ = 0; rp_ < NREP(4); ++rp_) { const int G = gridDim.x, bx = opaque_bid(); unsigned char* ws = PWS(); float* PS = (float*)(ws + WS_PS);
                pg8::Gemm g{(const bf16_t*)(ws + WS_XB), (const bf16_t*)(ws + WS_WIN) + (size_t)L * 4096 * 1024, MP, 4096, 1024}; pg8::StaticOrder S; S.init(MP, 4096, G, bx);
                pg8::EpiMlpIn<4> E{(bf16_t*)(ws + WS_H), PS, __builtin_amdgcn_make_buffer_rsrc((void*)ws, (short)0, (int)WS_END, 0x00020000)};
                pg8::gemm_phase<pg8::EpiMlpIn<4>, pg8::StaticOrder, true, true>(lds, g, S, E); }
            if (KON(9)) for (int rp_ = 0; rp_ < NREP(10); ++rp_) { GEO(); unsigned char* ws = PWS(); float* out = POUT(); sample_mlpin(L, lds, out + O_YS, (bf16_t*)(ws + WS_HS), vcu, G, wave, lane); }
        }
        SEAM(pb + 3);
        if (IN(pb + 4)) {
            if (KON(5)) { const int G = gridDim.x, bx = opaque_bid(); unsigned char* ws = PWS(); float* out = POUT(); float* PS = (float*)(ws + WS_PS);
                pg8::Gemm g{(const bf16_t*)(ws + WS_H), (const bf16_t*)(ws + WS_WOUT) + (size_t)L * 1024 * 4096, MP, 1024, 4096}; pg8::StaticOrder S; S.init(MP, 1024, G, bx);
                pg8::EpiResid E{(bf16_t*)(ws + WS_XB), (j == 0) ? nullptr : out + O_YP, (j == 0) ? PS : nullptr};
                pg8::gemm_phase<pg8::EpiResid, pg8::StaticOrder, false, true>(lds, g, S, E); }
            if (KON(9)) { GEO(); unsigned char* ws = PWS(); float* out = POUT(); sample_mlpout(L, lds, (const bf16_t*)(ws + WS_HS), out + O_YS, vcu, G, wave, lane); }
        }
        SEAM(pb + 4);
    }
#undef IN
#undef SEAM
}

extern "C" void kernel_launch(void* const* d_in, const int* in_sizes, int n_in, void* d_out, int out_size, void* d_ws, size_t ws_size, hipStream_t stream) {
    static int ready = 0;
    if (!ready) {
        (void)hipFuncSetAttribute((const void*)yoco_fwd, hipFuncAttributeMaxDynamicSharedMemorySize, LDS_BYTES);
        int per_cu = 0; (void)hipOccupancyMaxActiveBlocksPerMultiprocessor(&per_cu, (const void*)yoco_fwd, NWAVES * 64, LDS_BYTES);
        if (ws_size < WS_END) fprintf(stderr, "kernel_launch: workspace too small: %zu < %zu\n", ws_size, (size_t)WS_END);
        if (per_cu < 1) fprintf(stderr, "kernel_launch: occupancy query reports %d blocks per CU\n", per_cu);
        (void)hipGetLastError();
        ready = 1;
    }
    Args a{};
    for (int i = 0; i < 28; ++i) a.in[i] = (const float*)d_in[i];
    a.out = (float*)d_out; a.ws = (unsigned char*)d_ws;
    for (int d = 0; d < 32; ++d) a.inv[d] = powf(10000.0f, -(float)d / 32.0f);
    const int grid = 256;
#if MULTI
    for (int p = 0; p < NPH_RUN; ++p) { a.ph_lo = p; a.ph_hi = p + 1; hipLaunchKernelGGL(yoco_fwd, dim3(grid), dim3(NWAVES * 64), LDS_BYTES, stream, a); }
#else
    a.ph_lo = 0; a.ph_hi = NPHASE;
    (void)hipMemsetAsync(d_ws, 0, 16384, stream);
    void* kargs[] = {&a};
    hipError_t e = hipLaunchCooperativeKernel((const void*)yoco_fwd, dim3(grid), dim3(NWAVES * 64), kargs, LDS_BYTES, stream);
    if (e != hipSuccess) fprintf(stderr, "cooperative launch failed: %s\n", hipGetErrorString(e));
#endif
}
```
